# Optimizing an MI355X kernel written in HIP

```python
import math
import jax, jax.numpy as jnp
from jax import lax
import numpy as np

D_MODEL = 1024
BATCH = 32
SEQ = 256
DEPTH = 2
DEC_BATCH = 4
DEC_SEQ = 4096
PAST_LEN = 256

GRID_W = 64
NORM_EPS = 1e-6
SSD_HEADS = 8
SSD_HEAD_DIM = 64
SSD_STATE = 64
SSD_GROUPS = 2
SSD_CONV = 3
SSD_CHUNK = 64
SSD_WIDTH = SSD_HEADS * SSD_HEAD_DIM
SSD_BC = SSD_GROUPS * SSD_STATE
SSD_XBC = SSD_WIDTH + 2 * SSD_BC
SSD_IN = SSD_WIDTH + SSD_XBC + 2 * SSD_HEADS
NA_HEADS = 8
NA_HEAD_DIM = 64
NA_WIDTH = NA_HEADS * NA_HEAD_DIM
NA_IN = 3 * NA_WIDTH
NA_WIN_ROWS = 8
NA_WIN_COLS = 16
NA_SCALE = NA_HEAD_DIM ** -0.5
GLA_HEADS = 4
GLA_DK = 64
GLA_DV = 128
GLA_QK = GLA_HEADS * GLA_DK
GLA_V = GLA_HEADS * GLA_DV
GLA_RANK = 16
GLA_GATE_NORM = 16.0
HGRN_HEADS = 4
HGRN_DK = 64
HGRN_DV = 128
HGRN_QK = HGRN_HEADS * HGRN_DK
HGRN_V = HGRN_HEADS * HGRN_DV
LIN_CHUNK = 16
IN_L0 = SSD_IN + NA_IN
IN_L1 = 2 * GLA_QK + 2 * GLA_V + 2 * GLA_RANK + 3 * HGRN_QK + 2 * HGRN_V
MIX_OUT = D_MODEL
FFN_DIM = 2816
FFN_CONV = 3

kernel_name = 'hybrid_diffusion_trunk_step'


def _rms(x, w):
    xf = x.astype(jnp.float32)
    y = xf * lax.rsqrt(jnp.mean(xf * xf, axis=-1, keepdims=True) + NORM_EPS)
    return y.astype(x.dtype) * w


def _split(u, sizes):
    offs = [int(o) for o in np.cumsum(sizes)[:-1]]
    return jnp.split(u, offs, axis=-1)


def _heads(x, h):
    b, t, _ = x.shape
    return x.reshape(b, t, h, -1).transpose(0, 2, 1, 3)


def _unheads(x):
    b, h, t, d = x.shape
    return x.transpose(0, 2, 1, 3).reshape(b, t, h * d)


def _dwconv(x, w, b):
    k = w.shape[0]
    p = k // 2
    t = x.shape[1]
    xp = jnp.pad(x, ((0, 0), (p, p), (0, 0)))
    out = b
    for i in range(k):
        out = out + xp[:, i:i + t] * w[i]
    return out


def _chunk_scan(q, k, v, g, s0, chunk):
    out_dtype = q.dtype
    b, h, t, _ = q.shape
    dv = v.shape[-1]
    n = t // chunk

    def blk(a):
        return a.astype(jnp.float32).reshape(b, h, n, chunk, a.shape[-1])

    q, k, v, g = blk(q), blk(k), blk(v), blk(g)
    G = jnp.cumsum(g, axis=3)
    mask = jnp.tril(jnp.ones((chunk, chunk), bool))
    diff = G[:, :, :, :, None, :] - G[:, :, :, None, :, :]
    decay = jnp.exp(jnp.where(mask[:, :, None], diff, -jnp.inf))
    if g.shape[-1] == 1:
        scores = jnp.einsum('bhntd,bhnsd->bhnts', q, k) * decay[..., 0]
    else:
        scores = jnp.einsum('bhntd,bhnsd,bhntsd->bhnts', q, k, decay)
    o_intra = jnp.einsum('bhnts,bhnsv->bhntv', scores, v)
    G_last = G[:, :, :, -1:, :]
    q_in = q * jnp.exp(G)
    k_end = k * jnp.exp(G_last - G)
    d_last = jnp.exp(G_last[:, :, :, 0, :])

    def step(S, xs):
        qc, kc, vc, dc = xs
        o = jnp.einsum('bhtd,bhdv->bhtv', qc, S)
        S = dc[..., None] * S + jnp.einsum('bhtd,bhtv->bhdv', kc, vc)
        return S, o

    xs = (jnp.moveaxis(q_in, 2, 0), jnp.moveaxis(k_end, 2, 0), jnp.moveaxis(v, 2, 0), jnp.moveaxis(d_last, 2, 0))
    S, o_inter = lax.scan(step, s0.astype(jnp.float32), xs)
    o = o_intra + jnp.moveaxis(o_inter, 0, 2)
    return o.reshape(b, h, t, dv).astype(out_dtype), S


def _bidir(q, kf, kb, vf, vb, gf, gb, s0f, s0b, chunk):
    of, sf = _chunk_scan(q, kf, vf, gf, s0f, chunk)
    fl = lambda a: jnp.flip(a, axis=2)
    ob, sb = _chunk_scan(fl(q), fl(kb), fl(vb), fl(gb), s0b, chunk)
    return of + fl(ob), sf, sb


def _ssd(ua, conv_w, conv_b, dt_bias, a_log, d_skip, norm_w, s0f, s0b):
    bsz, t, _ = ua.shape
    z, xbc, dt_raw = _split(ua, [SSD_WIDTH, SSD_XBC, 2 * SSD_HEADS])
    xbc = jax.nn.silu(_dwconv(xbc, conv_w, conv_b))
    xs, bm, cm = _split(xbc, [SSD_WIDTH, SSD_BC, SSD_BC])
    x_h = _heads(xs, SSD_HEADS)
    rep = SSD_HEADS // SSD_GROUPS
    k = jnp.repeat(_heads(bm, SSD_GROUPS), rep, axis=1)
    q = jnp.repeat(_heads(cm, SSD_GROUPS), rep, axis=1)
    dt = jax.nn.softplus(dt_raw.reshape(bsz, t, 2, SSD_HEADS).astype(jnp.float32) + dt_bias)
    dt = dt.transpose(2, 0, 3, 1)
    a = -jnp.exp(a_log.astype(jnp.float32))
    g = (dt * a[:, None, :, None])[..., None]
    vf = x_h * dt[0][..., None]
    vb = x_h * dt[1][..., None]
    y, sf, sb = _bidir(q, k, k, vf, vb, g[0], g[1], s0f, s0b, SSD_CHUNK)
    y = y + d_skip[None, :, None, None] * x_h
    y = _unheads(y)
    return _rms(y * jax.nn.silu(z), norm_w), sf, sb


def _na_context(ub, q_norm, k_norm):
    q, k, v = [_heads(a, NA_HEADS) for a in _split(ub, [NA_WIDTH] * 3)]
    q = _rms(q, q_norm)
    k = _rms(k, k_norm)
    s = jnp.einsum('bhqd,bhkd->bhqk', q, k).astype(jnp.float32) * NA_SCALE
    p = jax.nn.softmax(s, axis=-1).astype(v.dtype)
    o = jnp.einsum('bhqk,bhkd->bhqd', p, v)
    return _unheads(o), k, v


def _na_latent(ub, k_ctx, v_ctx, q_norm, k_norm, rpb):
    bsz, t, _ = ub.shape
    rows = t // GRID_W
    wr = min(NA_WIN_ROWS, rows)
    q, k, v = [_heads(a, NA_HEADS) for a in _split(ub, [NA_WIDTH] * 3)]
    q = _rms(q, q_norm)
    k = _rms(k, k_norm)
    grid = lambda a: a.reshape(bsz, NA_HEADS, rows, GRID_W, NA_HEAD_DIM)
    q, k, v = grid(q), grid(k), grid(v)
    r = jnp.arange(rows)
    row_start = jnp.clip(r - wr // 2, 0, rows - wr)
    row_idx = row_start[:, None] + jnp.arange(wr)[None, :]
    n_loc = wr * GRID_W
    k_loc = k[:, :, row_idx].reshape(bsz, NA_HEADS, rows, n_loc, NA_HEAD_DIM)
    v_loc = v[:, :, row_idx].reshape(bsz, NA_HEADS, rows, n_loc, NA_HEAD_DIM)
    col = jnp.arange(GRID_W)
    col_start = jnp.clip(col - NA_WIN_COLS // 2, 0, GRID_W - NA_WIN_COLS)
    col_ok = (col[None, :] >= col_start[:, None]) & (col[None, :] < col_start[:, None] + NA_WIN_COLS)
    valid = jnp.tile(col_ok, (1, wr))
    d_row = row_idx - r[:, None] + (NA_WIN_ROWS - 1)
    d_col = jnp.clip(col[None, :] - col[:, None], -(NA_WIN_COLS - 1), NA_WIN_COLS - 1) + (NA_WIN_COLS - 1)
    bias = rpb[:, d_row][:, :, :, d_col]
    bias = bias.transpose(0, 1, 3, 2, 4).reshape(NA_HEADS, rows, GRID_W, n_loc)
    s_loc = jnp.einsum('bhrqd,bhrkd->bhrqk', q, k_loc).astype(jnp.float32) * NA_SCALE + bias
    s_loc = jnp.where(valid, s_loc, -jnp.inf)
    s_ctx = jnp.einsum('bhrqd,bhkd->bhrqk', q, k_ctx).astype(jnp.float32) * NA_SCALE
    p = jax.nn.softmax(jnp.concatenate([s_loc, s_ctx], axis=-1), axis=-1).astype(v.dtype)
    o = (jnp.einsum('bhrqk,bhrkd->bhrqd', p[..., :n_loc], v_loc)
         + jnp.einsum('bhrqk,bhkd->bhrqd', p[..., n_loc:], v_ctx))
    return _unheads(o.reshape(bsz, NA_HEADS, t, NA_HEAD_DIM))


def _mixer_ab(h, cache, w_in, w_out, conv_w, conv_b, dt_bias, a_log, d_skip, ssd_norm_w, q_norm, k_norm, rpb):
    u = h @ w_in
    ua, ub = _split(u, [SSD_IN, NA_IN])
    if cache is None:
        z0 = jnp.zeros((h.shape[0], SSD_HEADS, SSD_STATE, SSD_HEAD_DIM), jnp.float32)
        y_a, s_f, s_b = _ssd(ua, conv_w, conv_b, dt_bias, a_log, d_skip, ssd_norm_w, z0, z0)
        y_b, k_c, v_c = _na_context(ub, q_norm, k_norm)
        new = (k_c, v_c, s_f, s_b)
    else:
        k_c, v_c, s_f0, s_b0 = cache
        y_a, _, _ = _ssd(ua, conv_w, conv_b, dt_bias, a_log, d_skip, ssd_norm_w, s_f0, s_b0)
        y_b = _na_latent(ub, k_c, v_c, q_norm, k_norm, rpb)
        new = ()
    return jnp.concatenate([y_a, y_b], axis=-1) @ w_out, new


def _mixer_cd(h, cache, w_in, w_out, gla_wa2, gla_ba2, gla_norm_w, hgrn_lb, hgrn_norm_w):
    bsz = h.shape[0]
    u = h @ w_in
    gq, gk, gv, gg, gaf, gab, hq, hff, hfb, hi, hg = _split(
        u, [GLA_QK, GLA_QK, GLA_V, GLA_V, GLA_RANK, GLA_RANK, HGRN_QK, HGRN_QK, HGRN_QK, HGRN_V, HGRN_V])
    if cache is None:
        zg = jnp.zeros((bsz, GLA_HEADS, GLA_DK, GLA_DV), jnp.float32)
        zh = jnp.zeros((bsz, HGRN_HEADS, HGRN_DK, HGRN_DV), jnp.float32)
        s_gf, s_gb, s_hf, s_hb = zg, zg, zh, zh
    else:
        s_gf, s_gb, s_hf, s_hb = cache
    q = _heads(gq, GLA_HEADS) * GLA_DK ** -0.5
    k = _heads(gk, GLA_HEADS)
    v = _heads(gv, GLA_HEADS)
    la_f = _heads(jax.nn.log_sigmoid((gaf @ gla_wa2[0] + gla_ba2[0]).astype(jnp.float32)) / GLA_GATE_NORM, GLA_HEADS)
    la_b = _heads(jax.nn.log_sigmoid((gab @ gla_wa2[1] + gla_ba2[1]).astype(jnp.float32)) / GLA_GATE_NORM, GLA_HEADS)
    o_c, n_gf, n_gb = _bidir(q, k, k, v, v, la_f, la_b, s_gf, s_gb, LIN_CHUNK)
    y_c = _unheads(_rms(o_c, gla_norm_w) * jax.nn.silu(_heads(gg, GLA_HEADS)))
    f_f = hgrn_lb[0] + (1.0 - hgrn_lb[0]) * jax.nn.sigmoid(hff.astype(jnp.float32))
    f_b = hgrn_lb[1] + (1.0 - hgrn_lb[1]) * jax.nn.sigmoid(hfb.astype(jnp.float32))
    qh = _heads(hq, HGRN_HEADS)
    ih = _heads(hi, HGRN_HEADS)
    o_d, n_hf, n_hb = _bidir(qh, _heads(1.0 - f_f, HGRN_HEADS), _heads(1.0 - f_b, HGRN_HEADS), ih, ih,
                             _heads(jnp.log(f_f), HGRN_HEADS), _heads(jnp.log(f_b), HGRN_HEADS),
                             s_hf, s_hb, LIN_CHUNK)
    y_d = _unheads(_rms(o_d, hgrn_norm_w) * jax.nn.silu(_heads(hg, HGRN_HEADS)))
    new = (n_gf, n_gb, n_hf, n_hb) if cache is None else ()
    return jnp.concatenate([y_c, y_d], axis=-1) @ w_out, new


def _conv_ffn(h, w_up, conv_w, conv_b, w_down):
    u = _dwconv(h @ w_up, conv_w, conv_b)
    a, b = jnp.split(u, 2, axis=-1)
    return (jax.nn.silu(a) * b) @ w_down


def setup_inputs(seed: int = 0) -> dict:
    key = jax.random.key(seed)
    keys = iter(jax.random.split(key, 64))
    D = D_MODEL

    def nrm(shape, scale):
        return jax.random.normal(next(keys), shape, jnp.float32) * scale

    def gain(shape):
        return 1.0 + nrm(shape, 0.02)

    dt0 = jnp.exp(jax.random.uniform(next(keys), (2, SSD_HEADS), jnp.float32, math.log(1e-3), math.log(1e-1)))
    dt_bias = dt0 + jnp.log(-jnp.expm1(-dt0))
    a_log = jnp.log(jax.random.uniform(next(keys), (2, SSD_HEADS), jnp.float32, 1.0, 16.0))
    return {
        'x_prompt': nrm((BATCH, SEQ, D), 1.0),
        'x_sample': nrm((DEC_BATCH, DEC_SEQ, D), 1.0),
        'cache_na_k_l0': nrm((DEC_BATCH, NA_HEADS, PAST_LEN, NA_HEAD_DIM), 1.0),
        'cache_na_v_l0': nrm((DEC_BATCH, NA_HEADS, PAST_LEN, NA_HEAD_DIM), 1.0),
        'state_ssd_fwd_l0': nrm((DEC_BATCH, SSD_HEADS, SSD_STATE, SSD_HEAD_DIM), 0.5),
        'state_ssd_bwd_l0': nrm((DEC_BATCH, SSD_HEADS, SSD_STATE, SSD_HEAD_DIM), 0.5),
        'state_gla_fwd_l1': nrm((DEC_BATCH, GLA_HEADS, GLA_DK, GLA_DV), 0.5),
        'state_gla_bwd_l1': nrm((DEC_BATCH, GLA_HEADS, GLA_DK, GLA_DV), 0.5),
        'state_hgrn_fwd_l1': nrm((DEC_BATCH, HGRN_HEADS, HGRN_DK, HGRN_DV), 0.5),
        'state_hgrn_bwd_l1': nrm((DEC_BATCH, HGRN_HEADS, HGRN_DK, HGRN_DV), 0.5),
        'c': nrm((DEC_BATCH, D), 1.0),
        'c_ctx': nrm((D,), 1.0),
        'w_ada': nrm((DEPTH, D, 6 * D), 0.5 * D ** -0.5),
        'b_ada': nrm((DEPTH, 6 * D), 0.02),
        'norm_w': gain((DEPTH, 2, D)),
        'ffn_w_up': nrm((DEPTH, D, 2 * FFN_DIM), D ** -0.5),
        'ffn_conv_w': nrm((DEPTH, FFN_CONV, 2 * FFN_DIM), 0.5),
        'ffn_conv_b': nrm((DEPTH, 2 * FFN_DIM), 0.02),
        'ffn_w_down': nrm((DEPTH, FFN_DIM, D), FFN_DIM ** -0.5),
        'w_in_l0': nrm((D, IN_L0), D ** -0.5),
        'w_out_l0': nrm((MIX_OUT, D), MIX_OUT ** -0.5),
        'ssd_conv_w_l0': nrm((SSD_CONV, SSD_XBC), 0.5),
        'ssd_conv_b_l0': nrm((SSD_XBC,), 0.02),
        'ssd_dt_bias_l0': dt_bias,
        'ssd_a_log_l0': a_log,
        'ssd_d_l0': gain((SSD_HEADS,)),
        'ssd_norm_w_l0': gain((SSD_WIDTH,)),
        'na_q_norm_l0': gain((NA_HEAD_DIM,)),
        'na_k_norm_l0': gain((NA_HEAD_DIM,)),
        'na_rpb_l0': nrm((NA_HEADS, 2 * NA_WIN_ROWS - 1, 2 * NA_WIN_COLS - 1), 0.02),
        'w_in_l1': nrm((D, IN_L1), D ** -0.5),
        'w_out_l1': nrm((MIX_OUT, D), MIX_OUT ** -0.5),
        'gla_wa2_l1': nrm((2, GLA_RANK, GLA_QK), GLA_RANK ** -0.5),
        'gla_ba2_l1': nrm((2, GLA_QK), 0.1),
        'gla_norm_w_l1': gain((GLA_DV,)),
        'hgrn_lb_logits': nrm((2, DEPTH, HGRN_QK), 0.1),
        'hgrn_norm_w_l1': gain((HGRN_DV,)),
    }


def reference(x_prompt, x_sample, cache_na_k_l0, cache_na_v_l0, state_ssd_fwd_l0, state_ssd_bwd_l0,
              state_gla_fwd_l1, state_gla_bwd_l1, state_hgrn_fwd_l1, state_hgrn_bwd_l1, c,
              c_ctx, w_ada, b_ada, norm_w, ffn_w_up, ffn_conv_w, ffn_conv_b, ffn_w_down,
              w_in_l0, w_out_l0, ssd_conv_w_l0, ssd_conv_b_l0, ssd_dt_bias_l0, ssd_a_log_l0, ssd_d_l0,
              ssd_norm_w_l0, na_q_norm_l0, na_k_norm_l0, na_rpb_l0,
              w_in_l1, w_out_l1, gla_wa2_l1, gla_ba2_l1, gla_norm_w_l1, hgrn_lb_logits, hgrn_norm_w_l1):
    p_lb = jax.nn.softmax(hgrn_lb_logits.astype(jnp.float32), axis=1)
    lb_all = jnp.cumsum(p_lb, axis=1) - p_lb[:, :1]
    mixer_weights = (
        (w_in_l0, w_out_l0, ssd_conv_w_l0, ssd_conv_b_l0, ssd_dt_bias_l0, ssd_a_log_l0, ssd_d_l0,
         ssd_norm_w_l0, na_q_norm_l0, na_k_norm_l0, na_rpb_l0),
        (w_in_l1, w_out_l1, gla_wa2_l1, gla_ba2_l1, gla_norm_w_l1, lb_all[:, 1], hgrn_norm_w_l1),
    )
    caches = (
        (cache_na_k_l0, cache_na_v_l0, state_ssd_fwd_l0, state_ssd_bwd_l0),
        (state_gla_fwd_l1, state_gla_bwd_l1, state_hgrn_fwd_l1, state_hgrn_bwd_l1),
    )

    def run_layer(x, cvec, l, cache):
        mods = jax.nn.silu(cvec) @ w_ada[l] + b_ada[l]
        sh1, sc1, g1, sh2, sc2, g2 = jnp.split(mods[:, None, :], 6, axis=-1)
        h = _rms(x, norm_w[l, 0]) * (1.0 + sc1) + sh1
        mixer = _mixer_ab if l % 2 == 0 else _mixer_cd
        y, new = mixer(h, cache, *mixer_weights[l])
        x = x + g1 * y
        h = _rms(x, norm_w[l, 1]) * (1.0 + sc2) + sh2
        x = x + g2 * _conv_ffn(h, ffn_w_up[l], ffn_conv_w[l], ffn_conv_b[l], ffn_w_down[l])
        return x, new

    c_ctx_b = c_ctx[None, :]
    y_p, y_s = x_prompt, x_sample
    new_state = []
    for l in range(DEPTH):
        y_p, st = run_layer(y_p, c_ctx_b, l, None)
        new_state.append(st)
        y_s, _ = run_layer(y_s, c, l, caches[l])
    na_k0, na_v0, ssd_f0, ssd_b0 = new_state[0]
    gla_f1, gla_b1, hgrn_f1, hgrn_b1 = new_state[1]
    return (y_p, y_s, na_k0, na_v0, ssd_f0, ssd_b0, gla_f1, gla_b1, hgrn_f1, hgrn_b1)
```

```cpp
#include <hip/hip_runtime.h>
#include <hip/hip_cooperative_groups.h>
#include <cstdio>
namespace cg = cooperative_groups;

typedef unsigned short bf16_t;
typedef __attribute__((ext_vector_type(8))) short s8v;
typedef __attribute__((ext_vector_type(4))) float f4v;
typedef __attribute__((ext_vector_type(16))) float f16v;
typedef __attribute__((ext_vector_type(4))) unsigned u4v;

__device__ __forceinline__ int opaque_tid() { int t = threadIdx.x; asm volatile("" : "+v"(t)); return t; }

#define NTOK 24576
#define NPTOK 8192
#define DM 1024
#define UST 3360
#define FFN 2816
#define EPSV 1e-6f

#define OFF_WIN 0ull
#define OFF_WOUT 6881280ull
#define OFF_WUP 8978432ull
#define OFF_WDN 20512768ull
#define OFF_U 26279936ull
#define OFF_H 191430656ull
#define OFF_SL 241762304ull
#define OFF_DL 258539520ull
#define OFF_MODS 258801664ull
#define OFF_LB 259047424ull
#define OFF_BAR 259049472ull
#define OFF_ZROW 259063296ull
#define OFF_CKB 259071488ull
#define OFF_CVB 260120064ull

#define OUT_NAK 25165824ull
#define OUT_NAV 29360128ull
#define OUT_SSDF 33554432ull
#define OUT_SSDB 34603008ull
#define OUT_GLAF 35651584ull
#define OUT_GLAB 36700160ull
#define OUT_HGF 37748736ull
#define OUT_HGB 38797312ull

#define SMEM_BYTES 73728

struct Params {
  const float* in[37];
  float* out;
  unsigned char* ws;
};

enum {
  I_XP = 0, I_XS, I_CK, I_CV, I_SSDF, I_SSDB, I_GLAF, I_GLAB, I_HGF, I_HGB, I_C, I_CCTX, I_WADA, I_BADA, I_NORMW,
  I_WUP, I_FCW, I_FCB, I_WDN, I_WIN0, I_WOUT0, I_SCW, I_SCB, I_DTB, I_ALOG, I_SSDD, I_SSDNW, I_QN, I_KN, I_RPB,
  I_WIN1, I_WOUT1, I_WA2, I_BA2, I_GLANW, I_LBL, I_HGNW
};

typedef __bf16 bf2v __attribute__((ext_vector_type(2)));
typedef float f2v __attribute__((ext_vector_type(2)));
__device__ __forceinline__ unsigned pack2(float a, float b) {
  f2v v = {a, b};
  bf2v r = __builtin_convertvector(v, bf2v);
  return __builtin_bit_cast(unsigned, r);
}
__device__ __forceinline__ bf16_t f2bf(float f) { return (bf16_t)(pack2(f, f) & 0xffffu); }
__device__ __forceinline__ float bf2f(bf16_t h) { return __uint_as_float(((unsigned)h) << 16); }
__device__ __forceinline__ float bflo(unsigned w) { return __uint_as_float(w << 16); }
__device__ __forceinline__ float bfhi(unsigned w) { return __uint_as_float(w & 0xffff0000u); }
__device__ __forceinline__ float siluf(float x) { return x * __builtin_amdgcn_rcpf(1.f + __expf(-x)); }
__device__ __forceinline__ float sigmf(float x) { return __builtin_amdgcn_rcpf(1.f + __expf(-x)); }
__device__ __forceinline__ void unpack8(uint4 v, float* f) {
  f[0] = bflo(v.x); f[1] = bfhi(v.x); f[2] = bflo(v.y); f[3] = bfhi(v.y);
  f[4] = bflo(v.z); f[5] = bfhi(v.z); f[6] = bflo(v.w); f[7] = bfhi(v.w);
}
__device__ __forceinline__ void halves8(uint4 v, bf16_t* h) {
  h[0] = (bf16_t)(v.x & 0xffffu); h[1] = (bf16_t)(v.x >> 16); h[2] = (bf16_t)(v.y & 0xffffu); h[3] = (bf16_t)(v.y >> 16);
  h[4] = (bf16_t)(v.z & 0xffffu); h[5] = (bf16_t)(v.z >> 16); h[6] = (bf16_t)(v.w & 0xffffu); h[7] = (bf16_t)(v.w >> 16);
}
__device__ __forceinline__ uint4 pack8(const float* f) {
  uint4 v; v.x = pack2(f[0], f[1]); v.y = pack2(f[2], f[3]); v.z = pack2(f[4], f[5]); v.w = pack2(f[6], f[7]); return v;
}
__device__ __forceinline__ int condof(int row) { return row < NPTOK ? 0 : 1 + ((row - NPTOK) >> 12); }

template <int CTRL>
__device__ __forceinline__ float dppx(float v) { return __int_as_float(__builtin_amdgcn_update_dpp(0, __float_as_int(v), CTRL, 0xF, 0xF, true)); }
__device__ __forceinline__ float quad_sum(float v) { v += dppx<0xB1>(v); v += dppx<0x4E>(v); return v; }
__device__ __forceinline__ float red16_sum(float v) { v += dppx<0xB1>(v); v += dppx<0x4E>(v); v += dppx<0x141>(v); v += dppx<0x140>(v); return v; }
__device__ __forceinline__ float red16_max(float v) {
  v = fmaxf(v, dppx<0xB1>(v)); v = fmaxf(v, dppx<0x4E>(v)); v = fmaxf(v, dppx<0x141>(v)); v = fmaxf(v, dppx<0x140>(v)); return v;
}

#define MFMA16(a, b, c) __builtin_amdgcn_mfma_f32_16x16x32_bf16(a, b, c, 0, 0, 0)
#define MFMA32(a, b, c) __builtin_amdgcn_mfma_f32_32x32x16_bf16(a, b, c, 0, 0, 0)

#define XB_TMO      128
#define XB_XCNT(j)  (256  + 64 * (j))
#define XB_XSUB(j)  (1280 + 64 * (j))
#define XB_XGEN(j)  (2304 + 64 * (j))
#define XB_TOP      3328
#define XB_TOPGEN   3392
#define XCD_BAR_WORDS 3456
#define XB_SPIN_CAP (1u << 22)
#define LAS __attribute__((address_space(3)))
__device__ __forceinline__ unsigned xb_ld(unsigned* p) { return __hip_atomic_load(p, __ATOMIC_RELAXED, __HIP_MEMORY_SCOPE_AGENT); }
__device__ __forceinline__ unsigned xb_add(unsigned* p, unsigned v) { return __hip_atomic_fetch_add(p, v, __ATOMIC_RELAXED, __HIP_MEMORY_SCOPE_AGENT); }
__device__ __forceinline__ unsigned xb_xcc_id() { return (unsigned)__builtin_amdgcn_s_getreg((3 << 11) | 20) & 0xFu; }
#define XB_SPIN(cond, bar) do { unsigned _sp = 0; while (cond) { __builtin_amdgcn_s_sleep(1); \
    if ((++_sp & 255u) == 0u) { if (xb_ld(&(bar)[XB_TMO])) break; if (_sp > XB_SPIN_CAP) { atomicAdd(&(bar)[XB_TMO], 1u); break; } } } } while (0)
struct XcdBarrier { unsigned* bar; unsigned x; volatile LAS unsigned* st; };
__device__ __forceinline__ XcdBarrier xcd_barrier_post(unsigned* bar, volatile LAS unsigned* st) {
  XcdBarrier b; b.bar = bar; b.x = xb_xcc_id(); b.st = st;
  if (threadIdx.x == 0) (void)xb_add(&bar[XB_XCNT(b.x)], 1u);
  return b;
}
__device__ __forceinline__ void xcd_barrier_complete(unsigned* bar, unsigned x, unsigned& nloc, unsigned& nx) {
  const unsigned G = gridDim.x * gridDim.y * gridDim.z;
  unsigned sum, cnt, mine, sp = 0u;
  for (;;) {
    sum = 0u; cnt = 0u; mine = 0u;
#pragma unroll
    for (unsigned j = 0; j < 16; ++j) { const unsigned c = xb_ld(&bar[XB_XCNT(j)]); sum += c; cnt += (c > 0u) ? 1u : 0u; mine = (j == x) ? c : mine; }
    if (sum == G) break;
    __builtin_amdgcn_s_sleep(1);
    if ((++sp & 255u) == 0u) { if (xb_ld(&bar[XB_TMO])) break; if (sp > XB_SPIN_CAP) { atomicAdd(&bar[XB_TMO], 1u); break; } }
  }
  nloc = mine > 0u ? mine : 1u; nx = cnt > 0u ? cnt : 1u;
}
__device__ __forceinline__ void xcd_barrier(const XcdBarrier& b) {
  asm volatile("s_waitcnt vmcnt(0)" ::: "memory");
  __syncthreads();
  if (threadIdx.x == 0) {
    unsigned* bar = b.bar;
    __builtin_amdgcn_s_waitcnt(0);
    unsigned nloc = b.st[0], nx = b.st[1];
    if (nloc == 0u) { xcd_barrier_complete(bar, b.x, nloc, nx); b.st[0] = nloc; b.st[1] = nx; }
    const unsigned old = xb_add(&bar[XB_XSUB(b.x)], 1u);
    const unsigned gen = old / nloc;
    if (old + 1u == (gen + 1u) * nloc) {
      __builtin_amdgcn_fence(__ATOMIC_RELEASE, "agent");
      asm volatile("s_waitcnt vmcnt(0)" ::: "memory");
      const unsigned og = xb_add(&bar[XB_TOP], 1u);
      const unsigned tg = og / nx;
      if (og + 1u == (tg + 1u) * nx) xb_add(&bar[XB_TOPGEN], 1u);
      else XB_SPIN(xb_ld(&bar[XB_TOPGEN]) == tg, bar);
      __builtin_amdgcn_fence(__ATOMIC_ACQUIRE, "agent");
      xb_add(&bar[XB_XGEN(b.x)], 1u);
      asm volatile("s_waitcnt vmcnt(0)" ::: "memory");
    } else {
      XB_SPIN(xb_ld(&bar[XB_XGEN(b.x)]) == gen, bar);
      __builtin_amdgcn_fence(__ATOMIC_ACQUIRE, "agent");
      asm volatile("s_waitcnt vmcnt(0)" ::: "memory");
    }
  }
  __syncthreads();
}

__device__ __forceinline__ void convert_tile(const float* __restrict__ W, bf16_t* __restrict__ Wt, int K, int N, int tile, unsigned char* smem) {
  float* lds = (float*)smem;
  const int ntn = (N + 63) >> 6;
  const int kt = tile / ntn, nt = tile - kt * ntn;
  const int k0 = kt * 64, n0 = nt * 64;
  const int tid = opaque_tid();
  __syncthreads();
  {
    const int n = n0 + (tid & 63);
    const int nc = n < N ? n : N - 1;
    float v[16];
#pragma unroll
    for (int i = 0; i < 16; i++) v[i] = W[(unsigned)(k0 + (tid >> 6) + 4 * i) * N + nc];
#pragma unroll
    for (int i = 0; i < 16; i++) lds[(tid & 63) * 65 + (tid >> 6) + 4 * i] = v[i];
  }
  __syncthreads();
  const int nl = tid >> 2, kq = tid & 3;
  if (n0 + nl < N) {
    float f[16];
#pragma unroll
    for (int j = 0; j < 16; j++) f[j] = lds[nl * 65 + kq * 16 + j];
    uint4* dst = (uint4*)(Wt + (unsigned)(n0 + nl) * K + k0 + kq * 16);
    dst[0] = pack8(f);
    dst[1] = pack8(f + 8);
  }
}
__device__ __forceinline__ int convert_ntiles(int K, int N) { return (K >> 6) * ((N + 63) >> 6); }

__device__ __forceinline__ void mods_item(const Params& p, int item, unsigned char* smem) {
  float* sc = (float*)smem;
  float* red = sc + 5 * 1024;
  const int tid = opaque_tid();
  __syncthreads();
  for (int i = tid; i < 5 * 1024; i += 256) {
    int cv = i >> 10, k = i & 1023;
    float v = (cv == 0) ? p.in[I_CCTX][k] : p.in[I_C][(cv - 1) * 1024 + k];
    sc[i] = siluf(v);
  }
  __syncthreads();
  const int l = item / 384, n0 = (item % 384) * 16;
  const int nl = tid & 15, kp = tid >> 4;
  const float* W = p.in[I_WADA] + (unsigned)l * 1024 * 6144 + n0 + nl;
  float acc[5] = {0.f, 0.f, 0.f, 0.f, 0.f};
  for (int k0 = kp * 64; k0 < kp * 64 + 64; k0 += 32) {
    float wv[32];
#pragma unroll
    for (int j = 0; j < 32; j++) wv[j] = W[(unsigned)(k0 + j) * 6144];
#pragma unroll
    for (int j = 0; j < 32; j++)
#pragma unroll
      for (int cv = 0; cv < 5; cv++) acc[cv] += sc[cv * 1024 + k0 + j] * wv[j];
  }
#pragma unroll
  for (int cv = 0; cv < 5; cv++) red[(kp * 5 + cv) * 16 + nl] = acc[cv];
  __syncthreads();
  float* mods = (float*)(p.ws + OFF_MODS);
  if (tid < 5 * 16) {
    const int cv = tid >> 4, n = tid & 15;
    float s = 0.f;
#pragma unroll
    for (int q = 0; q < 16; q++) s += red[(q * 5 + cv) * 16 + n];
    mods[((unsigned)l * 5 + cv) * 6144 + n0 + n] = s + p.in[I_BADA][l * 6144 + n0 + n];
  }
  if (item == 0) {
    for (int i = tid; i < 2048; i += 256) ((unsigned*)(p.ws + OFF_ZROW))[i] = 0u;
    float* lb = (float*)(p.ws + OFF_LB);
    for (int i = tid; i < 512; i += 256) {
      int d = i >> 8, j = i & 255;
      float l0 = p.in[I_LBL][d * 512 + j], l1 = p.in[I_LBL][d * 512 + 256 + j];
      lb[i] = 1.f / (1.f + __expf(l0 - l1));
    }
  }
}

__device__ __forceinline__ void normmod_phase(const Params& p, int layer, int which  , bool from_input) {
  const float* mods = (const float*)(p.ws + OFF_MODS) + (unsigned)layer * 5 * 6144;
  const float* nw = p.in[I_NORMW] + (layer * 2 + which) * 1024;
  const int sh_off = which ? 3072 : 0, sc_off = which ? 4096 : 1024;
  bf16_t* hb = (bf16_t*)(p.ws + OFF_H);
  const int lane = opaque_tid() & 63, wave = opaque_tid() >> 6;
  for (int item = blockIdx.x; item < NTOK / 8; item += gridDim.x) {
    const int row = item * 8 + wave * 2;
    const float* x = from_input ? (row < NPTOK ? p.in[I_XP] + (unsigned)row * 1024 : p.in[I_XS] + (unsigned)(row - NPTOK) * 1024)
                                : p.out + (unsigned)row * 1024;
    const float* md = mods + condof(row) * 6144;
    float4 v[2][4];
    float ss0 = 0.f, ss1 = 0.f;
#pragma unroll
    for (int j = 0; j < 4; j++) {
      v[0][j] = ((const float4*)x)[lane + 64 * j];
      v[1][j] = ((const float4*)(x + 1024))[lane + 64 * j];
    }
    float4 wv[4], sv[4], hv[4];
#pragma unroll
    for (int j = 0; j < 4; j++) {
      const int col = 4 * (lane + 64 * j);
      wv[j] = *(const float4*)(nw + col);
      sv[j] = *(const float4*)(md + sc_off + col);
      hv[j] = *(const float4*)(md + sh_off + col);
    }
#pragma unroll
    for (int j = 0; j < 4; j++) {
      ss0 += v[0][j].x * v[0][j].x + v[0][j].y * v[0][j].y + v[0][j].z * v[0][j].z + v[0][j].w * v[0][j].w;
      ss1 += v[1][j].x * v[1][j].x + v[1][j].y * v[1][j].y + v[1][j].z * v[1][j].z + v[1][j].w * v[1][j].w;
    }
#pragma unroll
    for (int m = 32; m >= 1; m >>= 1) { ss0 += __shfl_xor(ss0, m); ss1 += __shfl_xor(ss1, m); }
    const float r0 = rsqrtf(ss0 * (1.f / 1024.f) + EPSV), r1 = rsqrtf(ss1 * (1.f / 1024.f) + EPSV);
#pragma unroll
    for (int j = 0; j < 4; j++) {
      const int col = 4 * (lane + 64 * j);
      const float4 w = wv[j], s = sv[j], h = hv[j];
      const float m0 = w.x * (1.f + s.x), m1 = w.y * (1.f + s.y), m2 = w.z * (1.f + s.z), m3 = w.w * (1.f + s.w);
      uint2 pk;
      pk.x = pack2(v[0][j].x * r0 * m0 + h.x, v[0][j].y * r0 * m1 + h.y);
      pk.y = pack2(v[0][j].z * r0 * m2 + h.z, v[0][j].w * r0 * m3 + h.w);
      *(uint2*)(hb + (unsigned)row * 1024 + col) = pk;
      pk.x = pack2(v[1][j].x * r1 * m0 + h.x, v[1][j].y * r1 * m1 + h.y);
      pk.y = pack2(v[1][j].z * r1 * m2 + h.z, v[1][j].w * r1 * m3 + h.w);
      *(uint2*)(hb + (unsigned)(row + 1) * 1024 + col) = pk;
    }
  }
}

#define G_STAGE_BYTES 24576
__device__ __forceinline__ void lds_dma16(unsigned voff, const void* sbase, unsigned lds_uniform) {
  asm volatile("s_mov_b32 m0, %2\n\ts_nop 0\n\tglobal_load_lds_dwordx4 %0, %1" ::"v"(voff), "s"(sbase), "s"(lds_uniform) : "memory");
}
template <class AF, class BF, class EF>
__device__ __forceinline__ void gemm_tile(const bf16_t* __restrict__ Abase, const bf16_t* __restrict__ Bbase, const bf16_t* __restrict__ zrow,
                                          AF arow, BF brow, int K, EF& epi, unsigned char* smem) {
  const int tid = opaque_tid() & 255, lane = tid & 63, wave = tid >> 6;
  const int wm = wave >> 1, wn = wave & 1;
  unsigned ao[4], bo[2];
  const int cch = ((lane & 3) ^ ((lane >> 4) & 3)) * 8;
  const int zoff = (int)(zrow - Abase);
#pragma unroll
  for (int i = 0; i < 4; i++) {
    const int row = (wave + 4 * i) * 16 + (lane >> 2);
    const int a = arow(row);
    ao[i] = (unsigned)(((a >= 0) ? a : zoff) + cch) * 2u;
  }
#pragma unroll
  for (int i = 0; i < 2; i++) {
    const int row = (wave + 4 * i) * 16 + (lane >> 2);
    bo[i] = (unsigned)(brow(row) + cch) * 2u;
  }
  f16v acc[4][2];
#pragma unroll
  for (int i = 0; i < 4; i++)
#pragma unroll
    for (int j = 0; j < 2; j++)
#pragma unroll
      for (int r = 0; r < 16; r++) acc[i][j][r] = 0.f;

  const unsigned lds0 = (unsigned)(size_t)((LAS unsigned char*)smem) + wave * 1024;
  auto stage = [&](int buf, int k0) __attribute__((always_inline)) {
    const unsigned la = __builtin_amdgcn_readfirstlane(lds0 + buf * G_STAGE_BYTES);
    const bf16_t* ab = Abase + k0;
    const bf16_t* bb = Bbase + k0;
#pragma unroll
    for (int i = 0; i < 4; i++) lds_dma16(ao[i], ab, la + i * 4096);
#pragma unroll
    for (int i = 0; i < 2; i++) lds_dma16(bo[i], bb, la + 16384 + i * 4096);
  };
  int xo[2];
#pragma unroll
  for (int kk = 0; kk < 2; kk++) xo[kk] = (((kk * 2 + (lane >> 5)) ^ ((lane >> 2) & 3)) * 16);
  const int arow_b = (wm * 128 + (lane & 31)) * 64;
  const int brow_b = 16384 + (wn * 64 + (lane & 31)) * 64;
  auto compute = [&](int buf) __attribute__((always_inline)) {
    const unsigned char* S = smem + buf * G_STAGE_BYTES;
    s8v a[2][4], b[2][2];
#pragma unroll
    for (int kk = 0; kk < 2; kk++) {
#pragma unroll
      for (int i = 0; i < 4; i++) a[kk][i] = *(const s8v*)(S + arow_b + i * 2048 + xo[kk]);
#pragma unroll
      for (int j = 0; j < 2; j++) b[kk][j] = *(const s8v*)(S + brow_b + j * 2048 + xo[kk]);
    }
#pragma unroll
    for (int kk = 0; kk < 2; kk++)
#pragma unroll
      for (int i = 0; i < 4; i++)
#pragma unroll
        for (int j = 0; j < 2; j++) acc[i][j] = MFMA32(a[kk][i], b[kk][j], acc[i][j]);
  };
  const int nk = K >> 5;
  stage(0, 0);
  stage(1, 32);
  asm volatile("s_waitcnt vmcnt(6)" ::: "memory");
  __syncthreads();
  int cur = 0;
#pragma unroll 1
  for (int kt = 0; kt < nk; kt++) {
    const bool more = (kt + 2 < nk);
    int nx = cur + 2; nx = nx >= 3 ? nx - 3 : nx;
    if (more) stage(nx, (kt + 2) << 5);
    compute(cur);
    if (more) asm volatile("s_waitcnt vmcnt(6)" ::: "memory");
    else asm volatile("s_waitcnt vmcnt(0)" ::: "memory");
    __syncthreads();
    cur = cur == 2 ? 0 : cur + 1;
  }
  epi(acc, wm, wn, lane, smem);
}

#define CROW(wm, i, reg, lane) ((wm) * 128 + (i) * 32 + ((reg) & 3) + 8 * ((reg) >> 2) + 4 * ((lane) >> 5))
#define CCOL(wn, j, lane) ((wn) * 64 + (j) * 32 + ((lane) & 31))

__device__ __forceinline__ bool tile_swizzle(int r, int MT8  , int NT, int& m, int& n) {
  const int bid = blockIdx.x, G = gridDim.x;
  const int per = G >> 3;
  const int total = MT8 * NT;
  const int full = total / G;
  int q;
  if (r < full && (G & 7) == 0) q = (r * 8 + (bid & 7)) * per + (bid >> 3);
  else if (r <= full) q = r * G + bid;
  else return false;
  q = __builtin_amdgcn_readfirstlane(q);
  if (q >= total) return false;
  const int sr = q / (8 * NT);
  const int rem = q - sr * 8 * NT;
  n = rem >> 3;
  m = sr * 8 + (rem & 7);
  return true;
}

struct ARowPlain {
  int ld;
  __device__ __forceinline__ int operator()(int i) const { return i * ld; }
};
struct BRowClamp {
  int ld; int n0; int N;
  __device__ __forceinline__ int operator()(int j) const { int n = n0 + j; n = n < N ? n : N - 1; return n * ld; }
};
struct EpiStoreU {
  bf16_t* u; int m0; int n0; int N;
  __device__ __forceinline__ void operator()(f16v (&acc)[4][2], int wm, int wn, int lane, unsigned char*) {
#pragma unroll
    for (int i = 0; i < 4; i++)
#pragma unroll
      for (int j = 0; j < 2; j++) {
        const int col = n0 + CCOL(wn, j, lane);
        if (col < N) {
#pragma unroll
          for (int r = 0; r < 16; r += 2) {
            const int row = m0 + CROW(wm, i, r, lane);
            const unsigned pk = pack2(acc[i][j][r], acc[i][j][r + 1]);
            u[(unsigned)row * UST + col] = (bf16_t)(pk & 0xffffu);
            u[(unsigned)(row + 1) * UST + col] = (bf16_t)(pk >> 16);
          }
        }
      }
  }
};
struct EpiResid {
  const float* xp; const float* xs; bool from_input; float* out; const float* gate;   int m0; int n0;
  __device__ __forceinline__ void operator()(f16v (&acc)[4][2], int wm, int wn, int lane, unsigned char*) {
    const float* g = gate + condof(m0) * 6144;
    const float* rsrc = from_input ? ((m0 < NPTOK) ? xp : (xs - (size_t)NPTOK * 1024)) : (const float*)out;
    const int col0 = n0 + CCOL(wn, 0, lane), col1 = n0 + CCOL(wn, 1, lane);
    const float gv0 = g[col0], gv1 = g[col1];
#pragma unroll
    for (int i = 0; i < 4; i++) {
      float res0[16], res1[16];
#pragma unroll
      for (int r = 0; r < 16; r++) {
        const unsigned ro = (unsigned)(m0 + CROW(wm, i, r, lane)) * 1024;
        res0[r] = rsrc[ro + col0];
        res1[r] = rsrc[ro + col1];
      }
#pragma unroll
      for (int r = 0; r < 16; r++) {
        const unsigned ro = (unsigned)(m0 + CROW(wm, i, r, lane)) * 1024;
        out[ro + col0] = res0[r] + gv0 * acc[i][0][r];
        out[ro + col1] = res1[r] + gv1 * acc[i][1][r];
      }
    }
  }
};
struct ARowHalo {
  int t0; int lo; int hi;
  __device__ __forceinline__ int operator()(int i) const { int t = t0 + i; return (t >= lo && t < hi) ? t * 1024 : -1; }
};
struct BRowUp {
  int n0;
  __device__ __forceinline__ int operator()(int j) const { int n = (j < 64) ? (n0 + j) : (FFN + n0 + j - 64); return n * 1024; }
};
struct EpiConv {
  bf16_t* act; const float* cw; const float* cb; int t0; int hi; int n0; bool halo;
  __device__ __forceinline__ void operator()(f16v (&acc)[4][2], int wm, int wn, int lane, unsigned char* smem) {
    bf16_t* sC = (bf16_t*)smem;
#pragma unroll
    for (int i = 0; i < 4; i++)
#pragma unroll
      for (int j = 0; j < 2; j++)
#pragma unroll
        for (int r = 0; r < 16; r += 2) {
          const unsigned pk = pack2(acc[i][j][r], acc[i][j][r + 1]);
          sC[CROW(wm, i, r, lane) * 136 + CCOL(wn, j, lane)] = (bf16_t)(pk & 0xffffu);
          sC[(CROW(wm, i, r, lane) + 1) * 136 + CCOL(wn, j, lane)] = (bf16_t)(pk >> 16);
        }
    __syncthreads();
    const int tid = opaque_tid() & 255;
    const int cp = tid & 31, rg = tid >> 5;
    const int ca = n0 + 2 * cp, cbi = FFN + n0 + 2 * cp;
    const float2 wa0 = *(const float2*)(cw + ca), wa1 = *(const float2*)(cw + 2 * FFN + ca), wa2 = *(const float2*)(cw + 4 * FFN + ca), ba = *(const float2*)(cb + ca);
    const float2 wb0 = *(const float2*)(cw + cbi), wb1 = *(const float2*)(cw + 2 * FFN + cbi), wb2 = *(const float2*)(cw + 4 * FFN + cbi), bb = *(const float2*)(cb + cbi);
    const int first = halo ? 1 : 0, last = halo ? 254 : 255;
    int ilo = 32 * rg, ihi = 32 * rg + 31;
    ilo = ilo < first ? first : ilo;
    ihi = ihi > last ? last : ihi;
    const bf16_t* sa = sC + 2 * cp;
    const bf16_t* sb = sC + 64 + 2 * cp;
    unsigned ap = ilo > 0 ? *(const unsigned*)(sa + (ilo - 1) * 136) : 0u, ac = *(const unsigned*)(sa + ilo * 136);
    unsigned bp = ilo > 0 ? *(const unsigned*)(sb + (ilo - 1) * 136) : 0u, bc = *(const unsigned*)(sb + ilo * 136);
    for (int i = ilo; i <= ihi; i++) {
      const unsigned an = i < 255 ? *(const unsigned*)(sa + (i + 1) * 136) : 0u;
      const unsigned bn = i < 255 ? *(const unsigned*)(sb + (i + 1) * 136) : 0u;
      const int tok = t0 + i;
      if (tok < hi) {
        const float a0 = ba.x + wa0.x * bflo(ap) + wa1.x * bflo(ac) + wa2.x * bflo(an);
        const float a1 = ba.y + wa0.y * bfhi(ap) + wa1.y * bfhi(ac) + wa2.y * bfhi(an);
        const float b0 = bb.x + wb0.x * bflo(bp) + wb1.x * bflo(bc) + wb2.x * bflo(bn);
        const float b1 = bb.y + wb0.y * bfhi(bp) + wb1.y * bfhi(bc) + wb2.y * bfhi(bn);
        *(unsigned*)(act + (unsigned)tok * FFN + n0 + 2 * cp) = pack2(siluf(a0) * b0, siluf(a1) * b1);
      }
      ap = ac; ac = an; bp = bc; bc = bn;
    }
    __syncthreads();
  }
};

__device__ __forceinline__ void attn_item(const Params& p, int item, unsigned char* smem) {
  bf16_t* sQ = (bf16_t*)smem;
  bf16_t* sK = sQ + 64 * 72;
  bf16_t* sVt = sK + 64 * 72;
  bf16_t* sP = sVt + 64 * 72;
  const bf16_t* u = (const bf16_t*)(p.ws + OFF_U);
  bf16_t* hb = (bf16_t*)(p.ws + OFF_H);
  const int tid = opaque_tid(), lane = tid & 63, w = tid >> 6;
  const bool latent = item >= 1024;
  int tq0, h, nkt, seq = 0, qt = 0, b = 0, r = 0, rs = 0;
  if (!latent) {
    seq = item >> 5; h = (item >> 2) & 7; qt = item & 3;
    tq0 = seq * 256 + qt * 64; nkt = 4;
  } else {
    const int it = item - 1024;
    b = it >> 9; h = (it >> 6) & 7; r = it & 63;
    tq0 = NPTOK + b * 4096 + r * 64; nkt = 12;
    rs = r - 4; rs = rs < 0 ? 0 : (rs > 56 ? 56 : rs);
  }
  const int lrow = tid >> 2, lq = tid & 3;
  __syncthreads();
  {
    const bf16_t* src = u + (unsigned)(tq0 + lrow) * UST + 1296 + h * 64 + lq * 16;
    float f[16];
    unpack8(*(const uint4*)src, f);
    unpack8(*(const uint4*)(src + 8), f + 8);
    float ss = 0.f;
#pragma unroll
    for (int j = 0; j < 16; j++) ss += f[j] * f[j];
    ss = quad_sum(ss);
    const float sc = rsqrtf(ss * (1.f / 64.f) + EPSV) * 0.125f;
    const float* qn = p.in[I_QN] + lq * 16;
#pragma unroll
    for (int j = 0; j < 16; j++) f[j] = f[j] * sc * qn[j];
    *(uint4*)(sQ + lrow * 72 + lq * 16) = pack8(f);
    *(uint4*)(sQ + lrow * 72 + lq * 16 + 8) = pack8(f + 8);
  }
  f4v o[4];
#pragma unroll
  for (int d = 0; d < 4; d++) o[d] = (f4v){0.f, 0.f, 0.f, 0.f};
  float m_run[4] = {-1e30f, -1e30f, -1e30f, -1e30f};
  float l_run[4] = {0.f, 0.f, 0.f, 0.f};
  float* sRPB = (float*)(smem + 4 * 64 * 72 * 2);
  if (latent) {
    const float r0 = p.in[I_RPB][h * 15 * 31 + tid];
    const float r1 = (tid + 256 < 15 * 31) ? p.in[I_RPB][h * 15 * 31 + tid + 256] : 0.f;
    sRPB[tid] = r0;
    if (tid + 256 < 15 * 31) sRPB[tid + 256] = r1;
  }
  float knr[16];
#pragma unroll
  for (int j = 0; j < 16; j++) knr[j] = p.in[I_KN][lq * 16 + j];

  const bf16_t* ckb = (const bf16_t*)(p.ws + OFF_CKB);
  const bf16_t* cvb = (const bf16_t*)(p.ws + OFF_CVB);
  auto tile_ptrs = [&](int kt, const bf16_t*& kp, const bf16_t*& vp) __attribute__((always_inline)) {
    if (latent && kt >= 8) {
      const size_t cb = ((size_t)(b * 8 + h) * 256 + (kt - 8) * 64 + lrow) * 64 + lq * 16;
      kp = ckb + cb; vp = cvb + cb;
    } else {
      const int tk0 = latent ? (NPTOK + b * 4096 + (rs + kt) * 64) : (seq * 256 + kt * 64);
      kp = u + (unsigned)(tk0 + lrow) * UST + 1296 + 512 + h * 64 + lq * 16;
      vp = kp + 512;
    }
  };
  uint4 kr0, kr1, vr0, vr1;
  {
    const bf16_t *kp, *vp;
    tile_ptrs(0, kp, vp);
    kr0 = *(const uint4*)kp; kr1 = *(const uint4*)(kp + 8);
    vr0 = *(const uint4*)vp; vr1 = *(const uint4*)(vp + 8);
  }
  for (int kt = 0; kt < nkt; kt++) {
    __syncthreads();
    const bool from_cache = latent && kt >= 8;
    {
      float f[16];
      unpack8(kr0, f); unpack8(kr1, f + 8);
      bf16_t vh[16];
      halves8(vr0, vh); halves8(vr1, vh + 8);
      const uint4 vs0 = vr0, vs1 = vr1;
      if (kt + 1 < nkt) {
        const bf16_t *kp, *vp;
        tile_ptrs(kt + 1, kp, vp);
        kr0 = *(const uint4*)kp; kr1 = *(const uint4*)(kp + 8);
        vr0 = *(const uint4*)vp; vr1 = *(const uint4*)(vp + 8);
      }
      if (!from_cache) {
        float ss = 0.f;
#pragma unroll
        for (int j = 0; j < 16; j++) ss += f[j] * f[j];
        ss = quad_sum(ss);
        const float sc = rsqrtf(ss * (1.f / 64.f) + EPSV);
#pragma unroll
        for (int j = 0; j < 16; j++) f[j] = f[j] * sc * knr[j];
      }
      *(uint4*)(sK + lrow * 72 + lq * 16) = pack8(f);
      *(uint4*)(sK + lrow * 72 + lq * 16 + 8) = pack8(f + 8);
#pragma unroll
      for (int j = 0; j < 16; j++) sVt[(lq * 16 + j) * 72 + lrow] = vh[j];
      if (!latent && kt == qt) {
        float g[16];
        unpack8(vs0, g); unpack8(vs1, g + 8);
        float* ok = p.out + OUT_NAK + ((unsigned)(seq * 8 + h) * 256 + kt * 64 + lrow) * 64 + lq * 16;
        float* ov = p.out + OUT_NAV + ((unsigned)(seq * 8 + h) * 256 + kt * 64 + lrow) * 64 + lq * 16;
#pragma unroll
        for (int j = 0; j < 16; j += 4) {
          *(float4*)(ok + j) = make_float4(f[j], f[j + 1], f[j + 2], f[j + 3]);
          *(float4*)(ov + j) = make_float4(g[j], g[j + 1], g[j + 2], g[j + 3]);
        }
      }
    }
    __syncthreads();
    f4v s[4];
    {
      const bf16_t* qa = sQ + (16 * w + (lane & 15)) * 72 + (lane >> 4) * 8;
      const s8v a0 = *(const s8v*)(qa);
      const s8v a1 = *(const s8v*)(qa + 32);
#pragma unroll
      for (int nt = 0; nt < 4; nt++) {
        const bf16_t* kb = sK + (nt * 16 + (lane & 15)) * 72 + (lane >> 4) * 8;
        f4v z = (f4v){0.f, 0.f, 0.f, 0.f};
        z = MFMA16(a0, *(const s8v*)(kb), z);
        z = MFMA16(a1, *(const s8v*)(kb + 32), z);
        s[nt] = z;
      }
    }
    if (latent && kt < 8) {
      const int drow = (rs + kt) - r + 7;
      const float* rp = sRPB + drow * 31;
#pragma unroll
      for (int nt = 0; nt < 4; nt++)
#pragma unroll
        for (int rr = 0; rr < 4; rr++) {
          const int cq = 16 * w + (lane >> 4) * 4 + rr;
          const int ck = nt * 16 + (lane & 15);
          int cs = cq - 8; cs = cs < 0 ? 0 : (cs > 48 ? 48 : cs);
          const bool valid = (ck >= cs) && (ck < cs + 16);
          const int dc = valid ? (ck - cq + 15) : 15;
          s[nt][rr] = valid ? (s[nt][rr] + rp[dc]) : -1e30f;
        }
    }
#pragma unroll
    for (int rr = 0; rr < 4; rr++) {
      float mx = fmaxf(fmaxf(s[0][rr], s[1][rr]), fmaxf(s[2][rr], s[3][rr]));
      mx = red16_max(mx);
      const float mn = fmaxf(m_run[rr], mx);
      const float alpha = __expf(m_run[rr] - mn);
      m_run[rr] = mn;
      float lp = 0.f;
      bf16_t* pr = sP + (16 * w + (lane >> 4) * 4 + rr) * 72 + (lane & 15);
      {
        const float p0 = __expf(s[0][rr] - mn), p1 = __expf(s[1][rr] - mn), p2 = __expf(s[2][rr] - mn), p3 = __expf(s[3][rr] - mn);
        lp = (p0 + p1) + (p2 + p3);
        const unsigned k01 = pack2(p0, p1), k23 = pack2(p2, p3);
        pr[0] = (bf16_t)(k01 & 0xffffu); pr[16] = (bf16_t)(k01 >> 16);
        pr[32] = (bf16_t)(k23 & 0xffffu); pr[48] = (bf16_t)(k23 >> 16);
      }
      l_run[rr] = l_run[rr] * alpha + lp;
#pragma unroll
      for (int d = 0; d < 4; d++) o[d][rr] *= alpha;
    }
    __syncthreads();
    {
      const bf16_t* pa = sP + (16 * w + (lane & 15)) * 72 + (lane >> 4) * 8;
      const s8v a0 = *(const s8v*)(pa);
      const s8v a1 = *(const s8v*)(pa + 32);
#pragma unroll
      for (int d = 0; d < 4; d++) {
        const bf16_t* vb = sVt + (d * 16 + (lane & 15)) * 72 + (lane >> 4) * 8;
        o[d] = MFMA16(a0, *(const s8v*)(vb), o[d]);
        o[d] = MFMA16(a1, *(const s8v*)(vb + 32), o[d]);
      }
    }
  }
#pragma unroll
  for (int rr = 0; rr < 4; rr++) {
    float l = l_run[rr];
    l = red16_sum(l);
    const float inv = __builtin_amdgcn_rcpf(l);
    const int tok = tq0 + 16 * w + (lane >> 4) * 4 + rr;
#pragma unroll
    for (int d = 0; d < 4; d++) hb[(unsigned)tok * 1024 + 512 + h * 64 + d * 16 + (lane & 15)] = f2bf(o[d][rr] * inv);
  }
}

#define SC_G 0
#define SC_PS 8192
#define SC_EGL 9216
#define SC_GS 9472
#define SC_RS 9600
#define SC_QS 10112
#define SC_QI 14720
#define SC_KS 19328
#define SC_KET 23936
#define SC_VT 29056
#define SC_P 39296
#define SC_ST 41856
#define SC_XH 60288
#define SC_WA 64896

template <int KIND, int DV>
__device__ __forceinline__ void scan_run(const Params& p, int seg, int hh, int dir, int mode, f4v (&S)[4][DV / 64], unsigned char* smem) {
  constexpr int NCT = DV / 64;
  constexpr int WDV = DV / 4;
  float* sG = (float*)(smem + SC_G);
  float* sPS = (float*)(smem + SC_PS);
  float* sEGL = (float*)(smem + SC_EGL);
  float* sGS = (float*)(smem + SC_GS);
  float* sRS = (float*)(smem + SC_RS);
  bf16_t* sQS = (bf16_t*)(smem + SC_QS);
  bf16_t* sQI = (bf16_t*)(smem + SC_QI);
  bf16_t* sKS = (bf16_t*)(smem + SC_KS);
  bf16_t* sKET = (bf16_t*)(smem + SC_KET);
  bf16_t* sVT = (bf16_t*)(smem + SC_VT);
  bf16_t* sP = (bf16_t*)(smem + SC_P);
  bf16_t* sST = (bf16_t*)(smem + SC_ST);
  bf16_t* sXH = (bf16_t*)(smem + SC_XH);
  float* sWA = (float*)(smem + SC_WA);
  bf16_t* u = (bf16_t*)(p.ws + OFF_U);
  bf16_t* hb = (bf16_t*)(p.ws + OFF_H);
  const int tid = opaque_tid(), lane = tid & 63, w = tid >> 6;
  const int li = tid >> 3, dg = tid & 7;
  const int tb = seg * 256;
  const bool prompt = seg < 32;

  __syncthreads();
  if (KIND == 1) {
    const float* wa = p.in[I_WA2] + dir * 16 * 256 + hh * 64;
    float t4[4];
#pragma unroll
    for (int i = 0; i < 4; i++) t4[i] = wa[((tid + 256 * i) >> 6) * 256 + ((tid + 256 * i) & 63)];
#pragma unroll
    for (int i = 0; i < 4; i++) sWA[tid + 256 * i] = t4[i];
  } else if (KIND == 2) {
    const float* lb = (const float*)(p.ws + OFF_LB) + dir * 256 + hh * 64;
    if (tid < 64) sWA[tid] = lb[tid];
  } else {
    float t3[3];
#pragma unroll
    for (int b3 = 0; b3 < 3; b3++) {
      const int i = tid + 256 * b3;
      const int blk = i >> 8, tap = (i >> 6) & 3, d = i & 63;
      const int ch = (blk == 0 ? 512 + (hh >> 2) * 64 : (blk == 1 ? 640 + (hh >> 2) * 64 : hh * 64)) + d;
      const float* srcp = tap < 3 ? (p.in[I_SCW] + tap * 768 + ch) : (p.in[I_SCB] + ch);
      t3[b3] = *srcp;
    }
#pragma unroll
    for (int b3 = 0; b3 < 3; b3++) sWA[tid + 256 * b3] = t3[b3];
  }
  float gtot[8];
#pragma unroll
  for (int j = 0; j < 8; j++) gtot[j] = 0.f;
  float bar[8];
#pragma unroll
  for (int j = 0; j < 8; j++) bar[j] = (KIND == 1) ? p.in[I_BA2][dir * 256 + hh * 64 + dg * 8 + j] : 0.f;
  float nwr[NCT];
#pragma unroll
  for (int ct = 0; ct < NCT; ct++) nwr[ct] = (KIND == 0) ? 0.f : ((KIND == 1) ? p.in[I_GLANW] : p.in[I_HGNW])[w * WDV + ct * 16 + (lane & 15)];
  float dtb = 0.f, aneg = 0.f, dsk = 0.f;
  if (KIND == 0) {
    dtb = p.in[I_DTB][dir * 8 + hh];
    aneg = -__expf(p.in[I_ALOG][dir * 8 + hh]);
    dsk = p.in[I_SSDD][hh];
  }
  __syncthreads();

  for (int c = 0; c < 8; c++) {
    if (mode != 0) {
#pragma unroll
      for (int kt = 0; kt < 4; kt++)
#pragma unroll
        for (int ct = 0; ct < NCT; ct++) {
          uint2 pk;
          pk.x = pack2(S[kt][ct][0], S[kt][ct][1]);
          pk.y = pack2(S[kt][ct][2], S[kt][ct][3]);
          *(uint2*)(sST + (w * WDV + ct * 16 + (lane & 15)) * 72 + kt * 16 + (lane >> 4) * 4) = pk;
        }
    }
    uint4 ofv0 = make_uint4(0, 0, 0, 0), ofv1 = make_uint4(0, 0, 0, 0);
    if (mode == 2) {
      const int tm = w * 64 + (3 - (lane >> 4)) * 16 + (lane & 15);
      const int tokm = tb + (7 - c) * 32 + (tm >> 3);
      const bf16_t* srcv = (KIND == 0) ? (u + (unsigned)tokm * UST + 2832 + hh * 64 + (tm & 7) * 8)
                                       : (hb + (unsigned)tokm * 1024 + (KIND - 1) * 512 + hh * 128 + (tm & 7) * 16);
      ofv0 = *(const uint4*)srcv;
      if (NCT == 2) ofv1 = *(const uint4*)(srcv + 8);
    }
    const int lidx = c * 32 + li;
    const int tok = tb + (dir ? (255 - lidx) : lidx);
    float q[8] = {0.f, 0.f, 0.f, 0.f, 0.f, 0.f, 0.f, 0.f}, k[8], g[8];
    if (KIND == 0) {
      const int pos = prompt ? (tok & 255) : (tok & 4095);
      const int T = prompt ? 256 : 4096;
      const bool hp = pos > 0, hn = pos < T - 1;
      const bf16_t* ur = u + (unsigned)tok * UST;
      const float dt_raw = bf2f(ur[1280 + dir * 8 + hh]) + dtb;
      const float dt = dt_raw > 20.f ? dt_raw : __logf(1.f + __expf(dt_raw));
      const float gg = aneg * dt;
#pragma unroll
      for (int j = 0; j < 8; j++) g[j] = gg;
      const int grp = hh >> 2;
      const uint4 z4 = make_uint4(0, 0, 0, 0);
      {
        const int col = 1024 + grp * 64 + dg * 8;
        float x0[8], x1[8], x2[8];
        unpack8(hp ? *(const uint4*)(ur - UST + col) : z4, x0);
        unpack8(*(const uint4*)(ur + col), x1);
        unpack8(hn ? *(const uint4*)(ur + UST + col) : z4, x2);
        const float* cw = sWA + 0 + dg * 8;
#pragma unroll
        for (int j = 0; j < 8; j++) k[j] = siluf(cw[192 + j] + cw[j] * x0[j] + cw[64 + j] * x1[j] + cw[128 + j] * x2[j]);
      }
      __builtin_amdgcn_sched_barrier(0);
      if (mode != 0) {
        const int col = 1152 + grp * 64 + dg * 8;
        float x0[8], x1[8], x2[8];
        unpack8(hp ? *(const uint4*)(ur - UST + col) : z4, x0);
        unpack8(*(const uint4*)(ur + col), x1);
        unpack8(hn ? *(const uint4*)(ur + UST + col) : z4, x2);
        const float* cw = sWA + 256 + dg * 8;
#pragma unroll
        for (int j = 0; j < 8; j++) q[j] = siluf(cw[192 + j] + cw[j] * x0[j] + cw[64 + j] * x1[j] + cw[128 + j] * x2[j]);
      }
      __builtin_amdgcn_sched_barrier(0);
      {
        const int col = 512 + hh * 64 + dg * 8;
        float x0[8], x1[8], x2[8];
        unpack8(hp ? *(const uint4*)(ur - UST + col) : z4, x0);
        unpack8(*(const uint4*)(ur + col), x1);
        unpack8(hn ? *(const uint4*)(ur + UST + col) : z4, x2);
        const float* cw = sWA + 512 + dg * 8;
        float xh[8];
#pragma unroll
        for (int j = 0; j < 8; j++) {
          xh[j] = siluf(cw[192 + j] + cw[j] * x0[j] + cw[64 + j] * x1[j] + cw[128 + j] * x2[j]);
          sVT[(dg * 8 + j) * 40 + li] = f2bf(xh[j] * dt);
        }
        if (mode == 2) *(uint4*)(sXH + li * 72 + dg * 8) = pack8(xh);
      }
    } else if (KIND == 1) {
      const bf16_t* ur = u + (unsigned)tok * UST;
      unpack8(*(const uint4*)(ur + hh * 64 + dg * 8), q);
      unpack8(*(const uint4*)(ur + 256 + hh * 64 + dg * 8), k);
#pragma unroll
      for (int j = 0; j < 8; j++) q[j] *= 0.125f;
      float ga[16];
      unpack8(*(const uint4*)(ur + 1536 + dir * 16), ga);
      unpack8(*(const uint4*)(ur + 1536 + dir * 16 + 8), ga + 8);
      float x[8];
#pragma unroll
      for (int j = 0; j < 8; j++) x[j] = bar[j];
#pragma unroll
      for (int rr = 0; rr < 16; rr++) {
        const float4 w0 = *(const float4*)(sWA + rr * 64 + dg * 8);
        const float4 w1 = *(const float4*)(sWA + rr * 64 + dg * 8 + 4);
        x[0] += ga[rr] * w0.x; x[1] += ga[rr] * w0.y; x[2] += ga[rr] * w0.z; x[3] += ga[rr] * w0.w;
        x[4] += ga[rr] * w1.x; x[5] += ga[rr] * w1.y; x[6] += ga[rr] * w1.z; x[7] += ga[rr] * w1.w;
      }
#pragma unroll
      for (int j = 0; j < 8; j++) g[j] = (fminf(x[j], 0.f) - __logf(1.f + __expf(-fabsf(x[j])))) * (1.f / 16.f);
      const bf16_t* vs = ur + 512 + hh * 128 + dg * 16;
      bf16_t vh[16];
      halves8(*(const uint4*)vs, vh);
      halves8(*(const uint4*)(vs + 8), vh + 8);
#pragma unroll
      for (int j = 0; j < 16; j++) sVT[(dg * 16 + j) * 40 + li] = vh[j];
    } else {
      const bf16_t* ur = u + (unsigned)tok * UST;
      unpack8(*(const uint4*)(ur + 1568 + hh * 64 + dg * 8), q);
      float fr[8];
      unpack8(*(const uint4*)(ur + 1824 + dir * 256 + hh * 64 + dg * 8), fr);
#pragma unroll
      for (int j = 0; j < 8; j++) {
        const float lbv = sWA[dg * 8 + j];
        const float f = lbv + (1.f - lbv) * sigmf(fr[j]);
        k[j] = 1.f - f;
        g[j] = __logf(f);
      }
      const bf16_t* vs = ur + 2336 + hh * 128 + dg * 16;
      bf16_t vh[16];
      halves8(*(const uint4*)vs, vh);
      halves8(*(const uint4*)(vs + 8), vh + 8);
#pragma unroll
      for (int j = 0; j < 16; j++) sVT[(dg * 16 + j) * 40 + li] = vh[j];
    }
    *(float4*)(sG + li * 64 + dg * 8) = make_float4(g[0], g[1], g[2], g[3]);
    *(float4*)(sG + li * 64 + dg * 8 + 4) = make_float4(g[4], g[5], g[6], g[7]);
    __syncthreads();
    {
      const int d = tid & 63, part = tid >> 6;
      float gv[8];
#pragma unroll
      for (int rr = 0; rr < 8; rr++) gv[rr] = sG[(part * 8 + rr) * 64 + d];
      float a = 0.f;
#pragma unroll
      for (int rr = 0; rr < 8; rr++) {
        a += gv[rr];
        sG[(part * 8 + rr) * 64 + d] = a;
      }
      sPS[part * 64 + d] = a;
    }
    __syncthreads();
    {
      float Gv[8], Gl[8];
      const float4 g0 = *(const float4*)(sG + li * 64 + dg * 8);
      const float4 g1 = *(const float4*)(sG + li * 64 + dg * 8 + 4);
      Gv[0] = g0.x; Gv[1] = g0.y; Gv[2] = g0.z; Gv[3] = g0.w; Gv[4] = g1.x; Gv[5] = g1.y; Gv[6] = g1.z; Gv[7] = g1.w;
      const int part = __builtin_amdgcn_readfirstlane(li >> 3);
#pragma unroll
      for (int j = 0; j < 8; j++) {
        const float p0 = sPS[dg * 8 + j], p1 = sPS[64 + dg * 8 + j], p2 = sPS[128 + dg * 8 + j], p3 = sPS[192 + dg * 8 + j];
        Gl[j] = p0 + p1 + p2 + p3;
        Gv[j] += (part > 0 ? p0 : 0.f) + (part > 1 ? p1 : 0.f) + (part > 2 ? p2 : 0.f);
      }
      float t[8];
#pragma unroll
      for (int j = 0; j < 8; j++) t[j] = k[j] * __expf(Gl[j] - Gv[j]);
#pragma unroll
      for (int j = 0; j < 8; j += 2) {
        const unsigned pk = pack2(t[j], t[j + 1]);
        sKET[(dg * 8 + j) * 40 + li] = (bf16_t)(pk & 0xffffu);
        sKET[(dg * 8 + j + 1) * 40 + li] = (bf16_t)(pk >> 16);
      }
      if (li == 0) {
#pragma unroll
        for (int j = 0; j < 8; j++) { sEGL[dg * 8 + j] = __expf(Gl[j]); gtot[j] += Gl[j]; }
      }
      if (mode != 0) {
        if (KIND == 0) {
          *(uint4*)(sQS + li * 72 + dg * 8) = pack8(q);
          *(uint4*)(sKS + li * 72 + dg * 8) = pack8(k);
#pragma unroll
          for (int j = 0; j < 8; j++) t[j] = q[j] * __expf(Gv[j]);
          *(uint4*)(sQI + li * 72 + dg * 8) = pack8(t);
          if (dg == 0) sGS[li] = Gv[0];
        } else {
#pragma unroll
          for (int j = 0; j < 8; j++) t[j] = q[j] * __expf(Gv[j]);
          const uint4 pq = pack8(t);
          *(uint4*)(sQS + li * 72 + dg * 8) = pq;
          *(uint4*)(sQI + li * 72 + dg * 8) = pq;
#pragma unroll
          for (int j = 0; j < 8; j++) t[j] = k[j] * __expf(-Gv[j]);
          *(uint4*)(sKS + li * 72 + dg * 8) = pack8(t);
        }
      }
    }
    __syncthreads();
    if (mode != 0) {
      const int ti = w >> 1, si = w & 1;
      const bf16_t* qa = sQS + (ti * 16 + (lane & 15)) * 72 + (lane >> 4) * 8;
      const bf16_t* kb = sKS + (si * 16 + (lane & 15)) * 72 + (lane >> 4) * 8;
      f4v z = (f4v){0.f, 0.f, 0.f, 0.f};
      z = MFMA16(*(const s8v*)(qa), *(const s8v*)(kb), z);
      z = MFMA16(*(const s8v*)(qa + 32), *(const s8v*)(kb + 32), z);
      const int scol = si * 16 + (lane & 15);
#pragma unroll
      for (int rr = 0; rr < 4; rr++) {
        const int trow = ti * 16 + (lane >> 4) * 4 + rr;
        float v = z[rr];
        if (KIND == 0) {
          const float df = sGS[trow] - sGS[scol];
          v *= __expf(fminf(df, 0.f));
        }
        v = (scol <= trow) ? v : 0.f;
        sP[trow * 40 + scol] = f2bf(v);
      }
    }
    __syncthreads();
    f4v o[2][NCT];
    if (mode != 0) {
#pragma unroll
      for (int rt = 0; rt < 2; rt++) {
        const s8v pa = *(const s8v*)(sP + (rt * 16 + (lane & 15)) * 40 + (lane >> 4) * 8);
        const bf16_t* qa = sQI + (rt * 16 + (lane & 15)) * 72 + (lane >> 4) * 8;
        const s8v q0 = *(const s8v*)(qa);
        const s8v q1 = *(const s8v*)(qa + 32);
#pragma unroll
        for (int ct = 0; ct < NCT; ct++) {
          const int vr = w * WDV + ct * 16 + (lane & 15);
          f4v z = (f4v){0.f, 0.f, 0.f, 0.f};
          z = MFMA16(pa, *(const s8v*)(sVT + vr * 40 + (lane >> 4) * 8), z);
          z = MFMA16(q0, *(const s8v*)(sST + vr * 72 + (lane >> 4) * 8), z);
          z = MFMA16(q1, *(const s8v*)(sST + vr * 72 + 32 + (lane >> 4) * 8), z);
          o[rt][ct] = z;
        }
      }
    }
#pragma unroll
    for (int kt = 0; kt < 4; kt++) {
      const s8v ka = *(const s8v*)(sKET + (kt * 16 + (lane & 15)) * 40 + (lane >> 4) * 8);
      const float4 eg = *(const float4*)(sEGL + kt * 16 + (lane >> 4) * 4);
#pragma unroll
      for (int ct = 0; ct < NCT; ct++) {
        const int vr = w * WDV + ct * 16 + (lane & 15);
        f4v z = S[kt][ct];
        z[0] *= eg.x; z[1] *= eg.y; z[2] *= eg.z; z[3] *= eg.w;
        S[kt][ct] = MFMA16(ka, *(const s8v*)(sVT + vr * 40 + (lane >> 4) * 8), z);
      }
    }
    if (mode == 1) {
      float pv[8 * NCT];
#pragma unroll
      for (int rt = 0; rt < 2; rt++)
#pragma unroll
        for (int rr = 0; rr < 4; rr++)
#pragma unroll
          for (int ct = 0; ct < NCT; ct++) pv[(rt * 4 + rr) * NCT + ct] = o[rt][ct][rr];
      const int tokf = tb + c * 32 + (tid >> 3);
      bf16_t* dst = (KIND == 0) ? (u + (unsigned)tokf * UST + 2832 + hh * 64 + (tid & 7) * 8)
                                : (hb + (unsigned)tokf * 1024 + (KIND - 1) * 512 + hh * 128 + (tid & 7) * 16);
      *(uint4*)dst = pack8(pv);
      if (NCT == 2) *(uint4*)(dst + 8) = pack8(pv + 8 * (NCT - 1));
    } else if (mode == 2) {
      float tot[2][NCT][4];
      float ssq[2][4];
      {
        float fv[8 * NCT];
        unpack8(ofv0, fv);
        if (NCT == 2) unpack8(ofv1, fv + 8 * (NCT - 1));
#pragma unroll
        for (int rt = 0; rt < 2; rt++)
#pragma unroll
          for (int rr = 0; rr < 4; rr++)
#pragma unroll
            for (int ct = 0; ct < NCT; ct++) tot[rt][ct][rr] = fv[((1 - rt) * 4 + (3 - rr)) * NCT + ct];
      }
      float gat[2][NCT][4];
      if (KIND != 0) {
        const int gcol = (KIND == 1) ? 1024 : 2848;
#pragma unroll
        for (int rt = 0; rt < 2; rt++)
#pragma unroll
          for (int rr = 0; rr < 4; rr++) {
            const int i = rt * 16 + (lane >> 4) * 4 + rr;
            const int li2 = c * 32 + i;
            const int tk = tb + (dir ? (255 - li2) : li2);
#pragma unroll
            for (int ct = 0; ct < NCT; ct++)
              gat[rt][ct][rr] = bf2f(u[(unsigned)tk * UST + gcol + hh * 128 + w * WDV + ct * 16 + (lane & 15)]);
          }
      }
#pragma unroll
      for (int rt = 0; rt < 2; rt++)
#pragma unroll
        for (int rr = 0; rr < 4; rr++) {
          const int i = rt * 16 + (lane >> 4) * 4 + rr;
          const int li2 = c * 32 + i;
          const int tk = tb + (dir ? (255 - li2) : li2);
          float sq = 0.f;
#pragma unroll
          for (int ct = 0; ct < NCT; ct++) {
            const int pc = w * WDV + ct * 16 + (lane & 15);
            float tv = o[rt][ct][rr] + tot[rt][ct][rr];
            if (KIND == 0) {
              tv += dsk * bf2f(sXH[i * 72 + pc]);
              u[(unsigned)tk * UST + 2832 + hh * 64 + pc] = f2bf(tv);
            }
            tot[rt][ct][rr] = tv;
            sq += tv * tv;
          }
          ssq[rt][rr] = sq;
        }
      if (KIND != 0) {
#pragma unroll
        for (int rt = 0; rt < 2; rt++)
#pragma unroll
          for (int rr = 0; rr < 4; rr++) {
            float sq = ssq[rt][rr];
            sq = red16_sum(sq);
            if ((lane & 15) == 0) sRS[w * 32 + rt * 16 + (lane >> 4) * 4 + rr] = sq;
          }
        __syncthreads();
#pragma unroll
        for (int rt = 0; rt < 2; rt++)
#pragma unroll
          for (int rr = 0; rr < 4; rr++) {
            const int i = rt * 16 + (lane >> 4) * 4 + rr;
            const int li2 = c * 32 + i;
            const int tk = tb + (dir ? (255 - li2) : li2);
            const float sq = sRS[i] + sRS[32 + i] + sRS[64 + i] + sRS[96 + i];
            const float scl = rsqrtf(sq * (1.f / 128.f) + EPSV);
#pragma unroll
            for (int ct = 0; ct < NCT; ct++) {
              const int pc = w * WDV + ct * 16 + (lane & 15);
              hb[(unsigned)tk * 1024 + (KIND - 1) * 512 + hh * 128 + pc] = f2bf(tot[rt][ct][rr] * scl * nwr[ct] * siluf(gat[rt][ct][rr]));
            }
          }
      }
    }
    __syncthreads();
  }
  if (mode == 0 && li == 0) {
#pragma unroll
    for (int j = 0; j < 8; j++) sEGL[dg * 8 + j] = __expf(gtot[j]);
  }
  __syncthreads();
}

template <int DV>
__device__ __forceinline__ void state_zero(f4v (&S)[4][DV / 64]) {
#pragma unroll
  for (int kt = 0; kt < 4; kt++)
#pragma unroll
    for (int ct = 0; ct < DV / 64; ct++) S[kt][ct] = (f4v){0.f, 0.f, 0.f, 0.f};
}
#define PIN_U4(a) asm volatile("" ::"v"((a).x), "v"((a).y), "v"((a).z), "v"((a).w) : "memory")
template <int DV>
__device__ __forceinline__ void state_load_f32(f4v (&S)[4][DV / 64], const float* src  , unsigned char* smem) {
  const int tid = opaque_tid(), lane = tid & 63, w = tid >> 6;
  float* l = (float*)smem;
  __syncthreads();
  {
    float4 t[DV / 16];
#pragma unroll
    for (int i = 0; i < DV / 16; i++) t[i] = ((const float4*)src)[tid + 256 * i];
#pragma unroll
    for (int i = 0; i < DV / 16; i++) PIN_U4(t[i]);
#pragma unroll
    for (int i = 0; i < DV / 16; i++) ((float4*)l)[tid + 256 * i] = t[i];
  }
  __syncthreads();
  const float* lb = l + ((lane >> 4) * 4) * DV + w * (DV / 4) + (lane & 15);
#pragma unroll
  for (int kt = 0; kt < 4; kt++)
#pragma unroll
    for (int ct = 0; ct < DV / 64; ct++)
#pragma unroll
      for (int r = 0; r < 4; r++) S[kt][ct][r] = lb[(kt * 16 + r) * DV + ct * 16];
}
template <int DV>
__device__ __forceinline__ void state_store_f32(const f4v (&S)[4][DV / 64], float* dst, unsigned char* smem) {
  const int tid = opaque_tid(), lane = tid & 63, w = tid >> 6;
  float* l = (float*)smem;
  __syncthreads();
  float* lb = l + ((lane >> 4) * 4) * DV + w * (DV / 4) + (lane & 15);
#pragma unroll
  for (int kt = 0; kt < 4; kt++)
#pragma unroll
    for (int ct = 0; ct < DV / 64; ct++)
#pragma unroll
      for (int r = 0; r < 4; r++) lb[(kt * 16 + r) * DV + ct * 16] = S[kt][ct][r];
  __syncthreads();
  {
    float4 t[DV / 16];
#pragma unroll
    for (int i = 0; i < DV / 16; i++) t[i] = ((const float4*)l)[tid + 256 * i];
#pragma unroll
    for (int i = 0; i < DV / 16; i++) ((float4*)dst)[tid + 256 * i] = t[i];
  }
}
template <int DV>
__device__ __forceinline__ void state_combine(f4v (&S)[4][DV / 64], const bf16_t* sl, const float* D, unsigned char* smem) {
  const int tid = opaque_tid(), lane = tid & 63, w = tid >> 6;
  bf16_t* l = (bf16_t*)smem;
  float* ld = (float*)(smem + 16384);
  __syncthreads();
  {
    uint4 t[4];
#pragma unroll
    for (int i = 0; i < 4; i++) t[i] = ((const uint4*)sl)[tid + 256 * i];
    const float dv = D[tid & 63];
#pragma unroll
    for (int i = 0; i < 4; i++) PIN_U4(t[i]);
    asm volatile("" ::"v"(dv) : "memory");
#pragma unroll
    for (int i = 0; i < 4; i++) ((uint4*)l)[tid + 256 * i] = t[i];
    if (tid < 64) ld[tid] = dv;
  }
  __syncthreads();
  const bf16_t* lb = l + ((lane >> 4) * 4) * 128 + w * (DV / 4) + (lane & 15);
  const float* ldb = ld + (lane >> 4) * 4;
#pragma unroll
  for (int kt = 0; kt < 4; kt++)
#pragma unroll
    for (int r = 0; r < 4; r++) {
      const float dd = ldb[kt * 16 + r];
#pragma unroll
      for (int ct = 0; ct < DV / 64; ct++) S[kt][ct][r] = S[kt][ct][r] * dd + bf2f(lb[(kt * 16 + r) * 128 + ct * 16]);
    }
}
template <int DV>
__device__ __forceinline__ void state_store_bf16(const f4v (&S)[4][DV / 64], bf16_t* dst, unsigned char* smem) {
  const int tid = opaque_tid(), lane = tid & 63, w = tid >> 6;
  bf16_t* l = (bf16_t*)smem;
  __syncthreads();
  bf16_t* lb = l + ((lane >> 4) * 4) * 128 + w * (DV / 4) + (lane & 15);
#pragma unroll
  for (int kt = 0; kt < 4; kt++)
#pragma unroll
    for (int ct = 0; ct < DV / 64; ct++)
#pragma unroll
      for (int r = 0; r < 4; r++) lb[(kt * 16 + r) * 128 + ct * 16] = f2bf(S[kt][ct][r]);
  __syncthreads();
  {
    uint4 t[4];
#pragma unroll
    for (int i = 0; i < 4; i++) t[i] = ((const uint4*)l)[tid + 256 * i];
#pragma unroll
    for (int i = 0; i < 4; i++) ((uint4*)dst)[tid + 256 * i] = t[i];
  }
}

template <int KIND, int DV>
__device__ __forceinline__ void scan_work(const Params& p, bool local, int seg, int hg, int hh, int ldir, const float* s0f, const float* s0b,
                                          float* outf, float* outb, int nheads, unsigned char* smem) {
  f4v S[4][DV / 64];
  const bf16_t* SL = (const bf16_t*)(p.ws + OFF_SL);
  const float* DL = (const float*)(p.ws + OFF_DL);
  const int npass = local ? 1 : 2;
  for (int pass = 0; pass < npass; pass++) {
    const int mode = local ? 0 : pass + 1;
    const int dir = local ? ldir : pass;
    state_zero<DV>(S);
    if (!local && seg >= 32) {
      const int sq = (seg - 32) >> 4, j = (seg - 32) & 15;
      state_load_f32<DV>(S, (dir ? s0b : s0f) + (unsigned)(sq * nheads + hh) * 64 * DV, smem);
      const int jbeg = dir ? 15 : 0, jstep = dir ? -1 : 1;
      for (int jj = jbeg; jj != j; jj += jstep) {
        const size_t idx = ((size_t)((sq * 16 + jj) * 8 + hg) * 2 + dir);
        state_combine<DV>(S, SL + idx * 8192, DL + idx * 64, smem);
      }
    }
    scan_run<KIND, DV>(p, seg, hh, dir, mode, S, smem);
    if (local) {
      const size_t idx = ((size_t)((seg - 32) * 8 + hg) * 2 + dir);
      if (opaque_tid() < 64) ((float*)(p.ws + OFF_DL))[idx * 64 + opaque_tid()] = ((float*)(smem + SC_EGL))[opaque_tid()];
      state_store_bf16<DV>(S, (bf16_t*)(p.ws + OFF_SL) + idx * 8192, smem);
    } else if (seg < 32) {
      state_store_f32<DV>(S, (dir ? outb : outf) + (unsigned)(seg * nheads + hh) * 64 * DV, smem);
    }
  }
}

__device__ __forceinline__ void ssd_post_phase(const Params& p) {
  const bf16_t* u = (const bf16_t*)(p.ws + OFF_U);
  bf16_t* hb = (bf16_t*)(p.ws + OFF_H);
  const int lane = opaque_tid() & 63, wave = opaque_tid() >> 6;
  const float* nw = p.in[I_SSDNW] + lane * 8;
  float nwv[8];
#pragma unroll
  for (int j = 0; j < 8; j++) nwv[j] = nw[j];
  for (int item = blockIdx.x; item < NTOK / 8; item += gridDim.x) {
    const int row = item * 8 + wave * 2;
    const uint4 ro0 = *(const uint4*)(u + (unsigned)row * UST + 2832 + lane * 8);
    const uint4 rz0 = *(const uint4*)(u + (unsigned)row * UST + lane * 8);
    const uint4 ro1 = *(const uint4*)(u + (unsigned)(row + 1) * UST + 2832 + lane * 8);
    const uint4 rz1 = *(const uint4*)(u + (unsigned)(row + 1) * UST + lane * 8);
    float o0[8], z0[8], o1[8], z1[8];
    unpack8(ro0, o0); unpack8(rz0, z0); unpack8(ro1, o1); unpack8(rz1, z1);
    float ss0 = 0.f, ss1 = 0.f;
#pragma unroll
    for (int j = 0; j < 8; j++) {
      o0[j] = o0[j] * siluf(z0[j]); ss0 += o0[j] * o0[j];
      o1[j] = o1[j] * siluf(z1[j]); ss1 += o1[j] * o1[j];
    }
#pragma unroll
    for (int m = 32; m >= 1; m >>= 1) { ss0 += __shfl_xor(ss0, m); ss1 += __shfl_xor(ss1, m); }
    const float r0 = rsqrtf(ss0 * (1.f / 512.f) + EPSV), r1 = rsqrtf(ss1 * (1.f / 512.f) + EPSV);
#pragma unroll
    for (int j = 0; j < 8; j++) { o0[j] = o0[j] * r0 * nwv[j]; o1[j] = o1[j] * r1 * nwv[j]; }
    *(uint4*)(hb + (unsigned)row * 1024 + lane * 8) = pack8(o0);
    *(uint4*)(hb + (unsigned)(row + 1) * 1024 + lane * 8) = pack8(o1);
  }
}

template <int layer>
__device__ __forceinline__ void layer_body(const Params& p, unsigned char* smem, const XcdBarrier& xb) {
  const int bid = blockIdx.x, nb = gridDim.x;
  bf16_t* Wt_in = (bf16_t*)(p.ws + OFF_WIN);
  bf16_t* Wt_out = (bf16_t*)(p.ws + OFF_WOUT);
  bf16_t* Wt_up = (bf16_t*)(p.ws + OFF_WUP);
  bf16_t* Wt_dn = (bf16_t*)(p.ws + OFF_WDN);
  bf16_t* ub = (bf16_t*)(p.ws + OFF_U);
  bf16_t* hb = (bf16_t*)(p.ws + OFF_H);
  const float* mods = (const float*)(p.ws + OFF_MODS);
  const bf16_t* zrow = (const bf16_t*)(p.ws + OFF_ZROW);
    const float* mods_l = mods + (unsigned)layer * 5 * 6144;
    const int NIN = layer == 0 ? 2832 : 3360;
    normmod_phase(p, layer, 0, layer == 0);
    xcd_barrier(xb);
    {
      const int NT = (NIN + 127) >> 7;
      for (int r = 0;; r++) {
        int mt, nt;
        if (!tile_swizzle(r, 96, NT, mt, nt)) break;
        ARowPlain af{1024};
        BRowClamp bf{1024, nt * 128, NIN};
        EpiStoreU ep{ub, mt * 256, nt * 128, NIN};
        gemm_tile(hb + (unsigned)mt * 256 * 1024, Wt_in, zrow, af, bf, 1024, ep, smem);
      }
    }
    xcd_barrier(xb);
    if (layer == 0) {
      for (int it = bid; it < 3072 + 1024; it += nb) {
        if (it < 2048) attn_item(p, 1024 + it, smem);
        else if (it < 3072) attn_item(p, it - 2048, smem);
        else {
          const int t = it - 3072;
          scan_work<0, 64>(p, true, 32 + (t >> 4), (t >> 1) & 7, (t >> 1) & 7, t & 1, nullptr, nullptr, nullptr, nullptr, 8, smem);
        }
      }
      xcd_barrier(xb);
      for (int it = bid; it < 768; it += nb) {
        const int seg = 95 - (it >> 3), hg = it & 7;
        scan_work<0, 64>(p, false, seg, hg, hg, 0, p.in[I_SSDF], p.in[I_SSDB], p.out + OUT_SSDF, p.out + OUT_SSDB, 8, smem);
      }
      {
        const int idle0 = (768 - nb) > 0 ? (768 - nb) : 0;
        const int n_in = convert_ntiles(1024, 3360), n_up = convert_ntiles(1024, 5632), n_dn = convert_ntiles(2816, 1024);
        if (bid >= idle0)
          for (int it = bid - idle0; it < 384 + n_in + n_up + n_dn; it += nb - idle0) {
            int t = it;
            if (t < 384) { mods_item(p, 384 + t, smem); continue; }
            t -= 384;
            if (t < n_in) { convert_tile(p.in[I_WIN1], Wt_in, 1024, 3360, t, smem); continue; }
            t -= n_in;
            if (t < n_up) { convert_tile(p.in[I_WUP], Wt_up, 1024, 5632, t, smem); continue; }
            t -= n_up;
            convert_tile(p.in[I_WDN], Wt_dn, 2816, 1024, t, smem);
          }
      }
      xcd_barrier(xb);
      ssd_post_phase(p);
      xcd_barrier(xb);
    } else {
      for (int t = bid; t < 1024; t += nb) {
        const int ss = t >> 4, hg = (t >> 1) & 7, dir = t & 1;
        if (hg < 4) scan_work<1, 128>(p, true, 32 + ss, hg, hg, dir, nullptr, nullptr, nullptr, nullptr, 4, smem);
        else scan_work<2, 128>(p, true, 32 + ss, hg, hg - 4, dir, nullptr, nullptr, nullptr, nullptr, 4, smem);
      }
      xcd_barrier(xb);
      for (int it = bid; it < 768; it += nb) {
        const int seg = 95 - (it >> 3), hg = it & 7;
        if (hg < 4) scan_work<1, 128>(p, false, seg, hg, hg, 0, p.in[I_GLAF], p.in[I_GLAB], p.out + OUT_GLAF, p.out + OUT_GLAB, 4, smem);
        else scan_work<2, 128>(p, false, seg, hg, hg - 4, 0, p.in[I_HGF], p.in[I_HGB], p.out + OUT_HGF, p.out + OUT_HGB, 4, smem);
      }
      {
        const int idle0 = (768 - nb) > 0 ? (768 - nb) : 0;
        const int n_up = convert_ntiles(1024, 5632), n_dn = convert_ntiles(2816, 1024);
        if (bid >= idle0)
          for (int it = bid - idle0; it < n_up + n_dn; it += nb - idle0) {
            if (it < n_up) convert_tile(p.in[I_WUP] + (unsigned)1024 * 5632, Wt_up, 1024, 5632, it, smem);
            else convert_tile(p.in[I_WDN] + (unsigned)2816 * 1024, Wt_dn, 2816, 1024, it - n_up, smem);
          }
      }
      xcd_barrier(xb);
    }
    {
      for (int r = 0;; r++) {
        int mt, nt;
        if (!tile_swizzle(r, 96, 8, mt, nt)) break;
        ARowPlain af{1024};
        BRowClamp bf{1024, nt * 128, 1024};
        EpiResid ep{p.in[I_XP], p.in[I_XS], layer == 0, p.out, mods_l + 2048, mt * 256, nt * 128};
        gemm_tile(hb + (unsigned)mt * 256 * 1024, Wt_out, zrow, af, bf, 1024, ep, smem);
      }
    }
    xcd_barrier(xb);
    normmod_phase(p, layer, 1, false);
    if (layer == 0) {
      const int n_out = convert_ntiles(1024, 1024);
      for (int it = bid; it < n_out; it += nb) convert_tile(p.in[I_WOUT1], Wt_out, 1024, 1024, it, smem);
    }
    xcd_barrier(xb);
    {
      bf16_t* act = ub;
      const float* cw = p.in[I_FCW] + (unsigned)layer * 3 * 5632;
      const float* cb = p.in[I_FCB] + (unsigned)layer * 5632;
      for (int r = 0;; r++) {
        int mt, nt;
        if (!tile_swizzle(r, 104, 44, mt, nt)) break;
        if (mt >= 100) continue;
        int lo, hi, t0;
        bool halo;
        if (mt < 32) { lo = mt * 256; hi = lo + 256; t0 = lo; halo = false; }
        else { const int m2 = mt - 32; const int sq = m2 / 17; const int j = m2 - sq * 17; lo = NPTOK + sq * 4096; hi = lo + 4096; t0 = lo + 254 * j - 1; halo = true; }
        ARowHalo af{t0, lo, hi};
        BRowUp bf{nt * 64};
        EpiConv ep{act, cw, cb, t0, hi, nt * 64, halo};
        gemm_tile(hb, Wt_up, zrow, af, bf, 1024, ep, smem);
      }
    }
    xcd_barrier(xb);
    {
      const bf16_t* act = ub;
      for (int r = 0;; r++) {
        int mt, nt;
        if (!tile_swizzle(r, 96, 8, mt, nt)) break;
        ARowPlain af{FFN};
        BRowClamp bf{FFN, nt * 128, 1024};
        EpiResid ep{p.in[I_XP], p.in[I_XS], false, p.out, mods_l + 5120, mt * 256, nt * 128};
        gemm_tile(act + (unsigned)mt * 256 * FFN, Wt_dn, zrow, af, bf, FFN, ep, smem);
      }
    }
    xcd_barrier(xb);
}

__global__ void __launch_bounds__(256, 2) __attribute__((amdgpu_waves_per_eu(2, 2))) mega(Params p) {
  __shared__ __align__(16) unsigned char smem[SMEM_BYTES];
  __shared__ uint4 xb_words;
  if (p.out == nullptr) { cg::grid_group grid = cg::this_grid(); grid.sync(); }
  if (threadIdx.x == 0) xb_words = make_uint4(0u, 0u, 0u, 0u);
  __syncthreads();
  const XcdBarrier xb = xcd_barrier_post((unsigned*)(p.ws + OFF_BAR), (volatile LAS unsigned*)&xb_words);
  const int bid = blockIdx.x, nb = gridDim.x;
  bf16_t* Wt_in = (bf16_t*)(p.ws + OFF_WIN);
  bf16_t* Wt_out = (bf16_t*)(p.ws + OFF_WOUT);
  bf16_t* Wt_up = (bf16_t*)(p.ws + OFF_WUP);
  bf16_t* Wt_dn = (bf16_t*)(p.ws + OFF_WDN);
  bf16_t* ub = (bf16_t*)(p.ws + OFF_U);
  bf16_t* hb = (bf16_t*)(p.ws + OFF_H);
  const float* mods = (const float*)(p.ws + OFF_MODS);

  {
    const int n_in = convert_ntiles(1024, 2832), n_out = convert_ntiles(1024, 1024);
    const int total = 384 + n_in + n_out;
    for (int it = bid; it < total; it += nb) {
      int t = it;
      if (t < 384) { mods_item(p, t, smem); continue; }
      t -= 384;
      if (t < n_in) { convert_tile(p.in[I_WIN0], Wt_in, 1024, 2832, t, smem); continue; }
      t -= n_in;
      convert_tile(p.in[I_WOUT0], Wt_out, 1024, 1024, t, smem);
    }
  }
  {
    const int g = blockIdx.x * 256 + (opaque_tid() & 255);
    for (int i = g; i < 131072; i += gridDim.x * 256) {
      const int which = i >> 16, e = (i & 65535) * 8;
      const float* src = (which ? p.in[I_CV] : p.in[I_CK]) + e;
      const float4 a = *(const float4*)src, c = *(const float4*)(src + 4);
      uint4 o; o.x = pack2(a.x, a.y); o.y = pack2(a.z, a.w); o.z = pack2(c.x, c.y); o.w = pack2(c.z, c.w);
      *(uint4*)((bf16_t*)(p.ws + (which ? OFF_CVB : OFF_CKB)) + e) = o;
    }
  }
  xcd_barrier(xb);

  layer_body<0>(p, smem, xb);
  layer_body<1>(p, smem, xb);
}

extern "C" void kernel_launch(void* const* d_in, const int* in_sizes, int n_in,
                              void* d_out, int out_size, void* d_ws, size_t ws_size,
                              hipStream_t stream) {
  static int grid_blocks = 0;
  if (!grid_blocks) {
    int dev = 0, cus = 0, per_cu = 0;
    (void)hipGetDevice(&dev);
    (void)hipDeviceGetAttribute(&cus, hipDeviceAttributeMultiprocessorCount, dev);
    (void)hipOccupancyMaxActiveBlocksPerMultiprocessor(&per_cu, mega, 256, 0);
    if (per_cu > 2) per_cu = 2;
    if (per_cu < 1) per_cu = 1;
    grid_blocks = cus * per_cu;
  }
  Params p{};
  for (int i = 0; i < 37; i++) p.in[i] = (const float*)d_in[i];
  p.out = (float*)d_out;
  p.ws = (unsigned char*)d_ws;
  void* args[] = {&p};
  (void)hipMemsetAsync((unsigned char*)d_ws + OFF_BAR, 0, XCD_BAR_WORDS * 4, stream);
  hipError_t e = hipLaunchCooperativeKernel((void*)mega, dim3(grid_blocks), dim3(256), args, 0, stream);
  if (e != hipSuccess) fprintf(stderr, "cooperative launch failed: %s (grid %d)\n", hipGetErrorString(e), grid_blocks);
}
```

```cpp
#include <hip/hip_runtime.h>
#include <hip/hip_cooperative_groups.h>
#include <cstdio>
namespace cg = cooperative_groups;

typedef unsigned short bf16_t;
typedef __attribute__((ext_vector_type(8))) short s8v;
typedef __attribute__((ext_vector_type(4))) float f4v;
typedef __attribute__((ext_vector_type(16))) float f16v;
typedef __attribute__((ext_vector_type(4))) unsigned u4v;

__device__ __forceinline__ int opaque_tid() { int t = threadIdx.x; asm volatile("" : "+v"(t)); return t; }

#define NTOK 24576
#define NPTOK 8192
#define DM 1024
#define UST 3360
#define FFN 2816
#define EPSV 1e-6f

#define OFF_WIN 0ull
#define OFF_WOUT 6881280ull
#define OFF_WUP 8978432ull
#define OFF_WDN 20512768ull
#define OFF_U 26279936ull
#define OFF_H 191430656ull
#define OFF_SL 241762304ull
#define OFF_DL 258539520ull
#define OFF_MODS 258801664ull
#define OFF_LB 259047424ull
#define OFF_BAR 259049472ull
#define OFF_ZROW 259063296ull
#define OFF_CKB 259071488ull
#define OFF_CVB 260120064ull

#define OUT_NAK 25165824ull
#define OUT_NAV 29360128ull
#define OUT_SSDF 33554432ull
#define OUT_SSDB 34603008ull
#define OUT_GLAF 35651584ull
#define OUT_GLAB 36700160ull
#define OUT_HGF 37748736ull
#define OUT_HGB 38797312ull

#define SMEM_BYTES 73728

struct Params {
  const float* in[37];
  float* out;
  unsigned char* ws;
};

enum {
  I_XP = 0, I_XS, I_CK, I_CV, I_SSDF, I_SSDB, I_GLAF, I_GLAB, I_HGF, I_HGB, I_C, I_CCTX, I_WADA, I_BADA, I_NORMW,
  I_WUP, I_FCW, I_FCB, I_WDN, I_WIN0, I_WOUT0, I_SCW, I_SCB, I_DTB, I_ALOG, I_SSDD, I_SSDNW, I_QN, I_KN, I_RPB,
  I_WIN1, I_WOUT1, I_WA2, I_BA2, I_GLANW, I_LBL, I_HGNW
};

typedef __bf16 bf2v __attribute__((ext_vector_type(2)));
typedef float f2v __attribute__((ext_vector_type(2)));
__device__ __forceinline__ unsigned pack2(float a, float b) {
  f2v v = {a, b};
  bf2v r = __builtin_convertvector(v, bf2v);
  return __builtin_bit_cast(unsigned, r);
}
__device__ __forceinline__ bf16_t f2bf(float f) { return (bf16_t)(pack2(f, f) & 0xffffu); }
__device__ __forceinline__ float bf2f(bf16_t h) { return __uint_as_float(((unsigned)h) << 16); }
__device__ __forceinline__ float bflo(unsigned w) { return __uint_as_float(w << 16); }
__device__ __forceinline__ float bfhi(unsigned w) { return __uint_as_float(w & 0xffff0000u); }
__device__ __forceinline__ float siluf(float x) { return x * __builtin_amdgcn_rcpf(1.f + __expf(-x)); }
__device__ __forceinline__ float sigmf(float x) { return __builtin_amdgcn_rcpf(1.f + __expf(-x)); }
__device__ __forceinline__ void unpack8(uint4 v, float* f) {
  f[0] = bflo(v.x); f[1] = bfhi(v.x); f[2] = bflo(v.y); f[3] = bfhi(v.y);
  f[4] = bflo(v.z); f[5] = bfhi(v.z); f[6] = bflo(v.w); f[7] = bfhi(v.w);
}
__device__ __forceinline__ void halves8(uint4 v, bf16_t* h) {
  h[0] = (bf16_t)(v.x & 0xffffu); h[1] = (bf16_t)(v.x >> 16); h[2] = (bf16_t)(v.y & 0xffffu); h[3] = (bf16_t)(v.y >> 16);
  h[4] = (bf16_t)(v.z & 0xffffu); h[5] = (bf16_t)(v.z >> 16); h[6] = (bf16_t)(v.w & 0xffffu); h[7] = (bf16_t)(v.w >> 16);
}
__device__ __forceinline__ uint4 pack8(const float* f) {
  uint4 v; v.x = pack2(f[0], f[1]); v.y = pack2(f[2], f[3]); v.z = pack2(f[4], f[5]); v.w = pack2(f[6], f[7]); return v;
}
__device__ __forceinline__ int condof(int row) { return row < NPTOK ? 0 : 1 + ((row - NPTOK) >> 12); }

template <int CTRL>
__device__ __forceinline__ float dppx(float v) { return __int_as_float(__builtin_amdgcn_update_dpp(0, __float_as_int(v), CTRL, 0xF, 0xF, true)); }
__device__ __forceinline__ float quad_sum(float v) { v += dppx<0xB1>(v); v += dppx<0x4E>(v); return v; }
__device__ __forceinline__ float red16_sum(float v) { v += dppx<0xB1>(v); v += dppx<0x4E>(v); v += dppx<0x141>(v); v += dppx<0x140>(v); return v; }
__device__ __forceinline__ float red16_max(float v) {
  v = fmaxf(v, dppx<0xB1>(v)); v = fmaxf(v, dppx<0x4E>(v)); v = fmaxf(v, dppx<0x141>(v)); v = fmaxf(v, dppx<0x140>(v)); return v;
}

#define MFMA16(a, b, c) __builtin_amdgcn_mfma_f32_16x16x32_bf16(a, b, c, 0, 0, 0)
#define MFMA32(a, b, c) __builtin_amdgcn_mfma_f32_32x32x16_bf16(a, b, c, 0, 0, 0)

#define XB_TMO      128
#define XB_XCNT(j)  (256  + 64 * (j))
#define XB_XSUB(j)  (1280 + 64 * (j))
#define XB_XGEN(j)  (2304 + 64 * (j))
#define XB_TOP      3328
#define XB_TOPGEN   3392
#define XCD_BAR_WORDS 3456
#define XB_SPIN_CAP (1u << 22)
#define LAS __attribute__((address_space(3)))
__device__ __forceinline__ unsigned xb_ld(unsigned* p) { return __hip_atomic_load(p, __ATOMIC_RELAXED, __HIP_MEMORY_SCOPE_AGENT); }
__device__ __forceinline__ unsigned xb_add(unsigned* p, unsigned v) { return __hip_atomic_fetch_add(p, v, __ATOMIC_RELAXED, __HIP_MEMORY_SCOPE_AGENT); }
__device__ __forceinline__ unsigned xb_xcc_id() { return (unsigned)__builtin_amdgcn_s_getreg((3 << 11) | 20) & 0xFu; }
#define XB_SPIN(cond, bar) do { unsigned _sp = 0; while (cond) { __builtin_amdgcn_s_sleep(1); \
    if ((++_sp & 255u) == 0u) { if (xb_ld(&(bar)[XB_TMO])) break; if (_sp > XB_SPIN_CAP) { atomicAdd(&(bar)[XB_TMO], 1u); break; } } } } while (0)
struct XcdBarrier { unsigned* bar; unsigned x; volatile LAS unsigned* st; };
__device__ __forceinline__ XcdBarrier xcd_barrier_post(unsigned* bar, volatile LAS unsigned* st) {
  XcdBarrier b; b.bar = bar; b.x = xb_xcc_id(); b.st = st;
  if (threadIdx.x == 0) (void)xb_add(&bar[XB_XCNT(b.x)], 1u);
  return b;
}
__device__ __forceinline__ void xcd_barrier_complete(unsigned* bar, unsigned x, unsigned& nloc, unsigned& nx) {
  const unsigned G = gridDim.x * gridDim.y * gridDim.z;
  unsigned sum, cnt, mine, sp = 0u;
  for (;;) {
    sum = 0u; cnt = 0u; mine = 0u;
#pragma unroll
    for (unsigned j = 0; j < 16; ++j) { const unsigned c = xb_ld(&bar[XB_XCNT(j)]); sum += c; cnt += (c > 0u) ? 1u : 0u; mine = (j == x) ? c : mine; }
    if (sum == G) break;
    __builtin_amdgcn_s_sleep(1);
    if ((++sp & 255u) == 0u) { if (xb_ld(&bar[XB_TMO])) break; if (sp > XB_SPIN_CAP) { atomicAdd(&bar[XB_TMO], 1u); break; } }
  }
  nloc = mine > 0u ? mine : 1u; nx = cnt > 0u ? cnt : 1u;
}
__device__ __forceinline__ void xcd_barrier(const XcdBarrier& b) {
  asm volatile("s_waitcnt vmcnt(0)" ::: "memory");
  __syncthreads();
  if (threadIdx.x == 0) {
    unsigned* bar = b.bar;
    __builtin_amdgcn_s_waitcnt(0);
    unsigned nloc = b.st[0], nx = b.st[1];
    if (nloc == 0u) { xcd_barrier_complete(bar, b.x, nloc, nx); b.st[0] = nloc; b.st[1] = nx; }
    const unsigned old = xb_add(&bar[XB_XSUB(b.x)], 1u);
    const unsigned gen = old / nloc;
    if (old + 1u == (gen + 1u) * nloc) {
      __builtin_amdgcn_fence(__ATOMIC_RELEASE, "agent");
      asm volatile("s_waitcnt vmcnt(0)" ::: "memory");
      const unsigned og = xb_add(&bar[XB_TOP], 1u);
      const unsigned tg = og / nx;
      if (og + 1u == (tg + 1u) * nx) xb_add(&bar[XB_TOPGEN], 1u);
      else XB_SPIN(xb_ld(&bar[XB_TOPGEN]) == tg, bar);
      __builtin_amdgcn_fence(__ATOMIC_ACQUIRE, "agent");
      xb_add(&bar[XB_XGEN(b.x)], 1u);
      asm volatile("s_waitcnt vmcnt(0)" ::: "memory");
    } else {
      XB_SPIN(xb_ld(&bar[XB_XGEN(b.x)]) == gen, bar);
      __builtin_amdgcn_fence(__ATOMIC_ACQUIRE, "agent");
      asm volatile("s_waitcnt vmcnt(0)" ::: "memory");
    }
  }
  __syncthreads();
}

__device__ __forceinline__ void convert_tile(const float* __restrict__ W, bf16_t* __restrict__ Wt, int K, int N, int tile, unsigned char* smem) {
  float* lds = (float*)smem;
  const int ntn = (N + 63) >> 6;
  const int kt = tile / ntn, nt = tile - kt * ntn;
  const int k0 = kt * 64, n0 = nt * 64;
  const int tid = opaque_tid();
  __syncthreads();
  {
    const int n = n0 + (tid & 63);
    const int nc = n < N ? n : N - 1;
    float v[16];
#pragma unroll
    for (int i = 0; i < 16; i++) v[i] = W[(unsigned)(k0 + (tid >> 6) + 4 * i) * N + nc];
#pragma unroll
    for (int i = 0; i < 16; i++) lds[(tid & 63) * 65 + (tid >> 6) + 4 * i] = v[i];
  }
  __syncthreads();
  const int nl = tid >> 2, kq = tid & 3;
  if (n0 + nl < N) {
    float f[16];
#pragma unroll
    for (int j = 0; j < 16; j++) f[j] = lds[nl * 65 + kq * 16 + j];
    uint4* dst = (uint4*)(Wt + (unsigned)(n0 + nl) * K + k0 + kq * 16);
    dst[0] = pack8(f);
    dst[1] = pack8(f + 8);
  }
}
__device__ __forceinline__ int convert_ntiles(int K, int N) { return (K >> 6) * ((N + 63) >> 6); }

__device__ __forceinline__ void mods_item(const Params& p, int item, unsigned char* smem) {
  float* sc = (float*)smem;
  float* red = sc + 5 * 1024;
  const int tid = opaque_tid();
  __syncthreads();
  for (int i = tid; i < 5 * 1024; i += 256) {
    int cv = i >> 10, k = i & 1023;
    float v = (cv == 0) ? p.in[I_CCTX][k] : p.in[I_C][(cv - 1) * 1024 + k];
    sc[i] = siluf(v);
  }
  __syncthreads();
  const int l = item / 384, n0 = (item % 384) * 16;
  const int nl = tid & 15, kp = tid >> 4;
  const float* W = p.in[I_WADA] + (unsigned)l * 1024 * 6144 + n0 + nl;
  float acc[5] = {0.f, 0.f, 0.f, 0.f, 0.f};
  for (int k0 = kp * 64; k0 < kp * 64 + 64; k0 += 32) {
    float wv[32];
#pragma unroll
    for (int j = 0; j < 32; j++) wv[j] = W[(unsigned)(k0 + j) * 6144];
#pragma unroll
    for (int j = 0; j < 32; j++)
#pragma unroll
      for (int cv = 0; cv < 5; cv++) acc[cv] += sc[cv * 1024 + k0 + j] * wv[j];
  }
#pragma unroll
  for (int cv = 0; cv < 5; cv++) red[(kp * 5 + cv) * 16 + nl] = acc[cv];
  __syncthreads();
  float* mods = (float*)(p.ws + OFF_MODS);
  if (tid < 5 * 16) {
    const int cv = tid >> 4, n = tid & 15;
    float s = 0.f;
#pragma unroll
    for (int q = 0; q < 16; q++) s += red[(q * 5 + cv) * 16 + n];
    mods[((unsigned)l * 5 + cv) * 6144 + n0 + n] = s + p.in[I_BADA][l * 6144 + n0 + n];
  }
  if (item == 0) {
    for (int i = tid; i < 2048; i += 256) ((unsigned*)(p.ws + OFF_ZROW))[i] = 0u;
    float* lb = (float*)(p.ws + OFF_LB);
    for (int i = tid; i < 512; i += 256) {
      int d = i >> 8, j = i & 255;
      float l0 = p.in[I_LBL][d * 512 + j], l1 = p.in[I_LBL][d * 512 + 256 + j];
      lb[i] = 1.f / (1.f + __expf(l0 - l1));
    }
  }
}

__device__ __forceinline__ void normmod_phase(const Params& p, int layer, int which  , bool from_input) {
  const float* mods = (const float*)(p.ws + OFF_MODS) + (unsigned)layer * 5 * 6144;
  const float* nw = p.in[I_NORMW] + (layer * 2 + which) * 1024;
  const int sh_off = which ? 3072 : 0, sc_off = which ? 4096 : 1024;
  bf16_t* hb = (bf16_t*)(p.ws + OFF_H);
  const int lane = opaque_tid() & 63, wave = opaque_tid() >> 6;
  for (int item = blockIdx.x; item < NTOK / 8; item += gridDim.x) {
    const int row = item * 8 + wave * 2;
    const float* x = from_input ? (row < NPTOK ? p.in[I_XP] + (unsigned)row * 1024 : p.in[I_XS] + (unsigned)(row - NPTOK) * 1024)
                                : p.out + (unsigned)row * 1024;
    const float* md = mods + condof(row) * 6144;
    float4 v[2][4];
    float ss0 = 0.f, ss1 = 0.f;
#pragma unroll
    for (int j = 0; j < 4; j++) {
      v[0][j] = ((const float4*)x)[lane + 64 * j];
      v[1][j] = ((const float4*)(x + 1024))[lane + 64 * j];
    }
    float4 wv[4], sv[4], hv[4];
#pragma unroll
    for (int j = 0; j < 4; j++) {
      const int col = 4 * (lane + 64 * j);
      wv[j] = *(const float4*)(nw + col);
      sv[j] = *(const float4*)(md + sc_off + col);
      hv[j] = *(const float4*)(md + sh_off + col);
    }
#pragma unroll
    for (int j = 0; j < 4; j++) {
      ss0 += v[0][j].x * v[0][j].x + v[0][j].y * v[0][j].y + v[0][j].z * v[0][j].z + v[0][j].w * v[0][j].w;
      ss1 += v[1][j].x * v[1][j].x + v[1][j].y * v[1][j].y + v[1][j].z * v[1][j].z + v[1][j].w * v[1][j].w;
    }
#pragma unroll
    for (int m = 32; m >= 1; m >>= 1) { ss0 += __shfl_xor(ss0, m); ss1 += __shfl_xor(ss1, m); }
    const float r0 = rsqrtf(ss0 * (1.f / 1024.f) + EPSV), r1 = rsqrtf(ss1 * (1.f / 1024.f) + EPSV);
#pragma unroll
    for (int j = 0; j < 4; j++) {
      const int col = 4 * (lane + 64 * j);
      const float4 w = wv[j], s = sv[j], h = hv[j];
      const float m0 = w.x * (1.f + s.x), m1 = w.y * (1.f + s.y), m2 = w.z * (1.f + s.z), m3 = w.w * (1.f + s.w);
      uint2 pk;
      pk.x = pack2(v[0][j].x * r0 * m0 + h.x, v[0][j].y * r0 * m1 + h.y);
      pk.y = pack2(v[0][j].z * r0 * m2 + h.z, v[0][j].w * r0 * m3 + h.w);
      *(uint2*)(hb + (unsigned)row * 1024 + col) = pk;
      pk.x = pack2(v[1][j].x * r1 * m0 + h.x, v[1][j].y * r1 * m1 + h.y);
      pk.y = pack2(v[1][j].z * r1 * m2 + h.z, v[1][j].w * r1 * m3 + h.w);
      *(uint2*)(hb + (unsigned)(row + 1) * 1024 + col) = pk;
    }
  }
}

#define G_STAGE_BYTES 24576
__device__ __forceinline__ void lds_dma16(unsigned voff, const void* sbase, unsigned lds_uniform) {
  asm volatile("s_mov_b32 m0, %2\n\ts_nop 0\n\tglobal_load_lds_dwordx4 %0, %1" ::"v"(voff), "s"(sbase), "s"(lds_uniform) : "memory");
}
template <class AF, class BF, class EF>
__device__ __forceinline__ void gemm_tile(const bf16_t* __restrict__ Abase, const bf16_t* __restrict__ Bbase, const bf16_t* __restrict__ zrow,
                                          AF arow, BF brow, int K, EF& epi, unsigned char* smem) {
  const int tid = opaque_tid() & 255, lane = tid & 63, wave = tid >> 6;
  const int wm = wave >> 1, wn = wave & 1;
  unsigned ao[4], bo[2];
  const int cch = ((lane & 3) ^ ((lane >> 4) & 3)) * 8;
  const int zoff = (int)(zrow - Abase);
#pragma unroll
  for (int i = 0; i < 4; i++) {
    const int row = (wave + 4 * i) * 16 + (lane >> 2);
    const int a = arow(row);
    ao[i] = (unsigned)(((a >= 0) ? a : zoff) + cch) * 2u;
  }
#pragma unroll
  for (int i = 0; i < 2; i++) {
    const int row = (wave + 4 * i) * 16 + (lane >> 2);
    bo[i] = (unsigned)(brow(row) + cch) * 2u;
  }
  f16v acc[4][2];
#pragma unroll
  for (int i = 0; i < 4; i++)
#pragma unroll
    for (int j = 0; j < 2; j++)
#pragma unroll
      for (int r = 0; r < 16; r++) acc[i][j][r] = 0.f;

  const unsigned lds0 = (unsigned)(size_t)((LAS unsigned char*)smem) + wave * 1024;
  auto stage = [&](int buf, int k0) __attribute__((always_inline)) {
    const unsigned la = __builtin_amdgcn_readfirstlane(lds0 + buf * G_STAGE_BYTES);
    const bf16_t* ab = Abase + k0;
    const bf16_t* bb = Bbase + k0;
#pragma unroll
    for (int i = 0; i < 4; i++) lds_dma16(ao[i], ab, la + i * 4096);
#pragma unroll
    for (int i = 0; i < 2; i++) lds_dma16(bo[i], bb, la + 16384 + i * 4096);
  };
  int xo[2];
#pragma unroll
  for (int kk = 0; kk < 2; kk++) xo[kk] = (((kk * 2 + (lane >> 5)) ^ ((lane >> 2) & 3)) * 16);
  const int arow_b = (wm * 128 + (lane & 31)) * 64;
  const int brow_b = 16384 + (wn * 64 + (lane & 31)) * 64;
  auto compute = [&](int buf) __attribute__((always_inline)) {
    const unsigned char* S = smem + buf * G_STAGE_BYTES;
    s8v a[2][4], b[2][2];
#pragma unroll
    for (int kk = 0; kk < 2; kk++) {
#pragma unroll
      for (int i = 0; i < 4; i++) a[kk][i] = *(const s8v*)(S + arow_b + i * 2048 + xo[kk]);
#pragma unroll
      for (int j = 0; j < 2; j++) b[kk][j] = *(const s8v*)(S + brow_b + j * 2048 + xo[kk]);
    }
#pragma unroll
    for (int kk = 0; kk < 2; kk++)
#pragma unroll
      for (int i = 0; i < 4; i++)
#pragma unroll
        for (int j = 0; j < 2; j++) acc[i][j] = MFMA32(a[kk][i], b[kk][j], acc[i][j]);
  };
  const int nk = K >> 5;
  stage(0, 0);
  stage(1, 32);
  asm volatile("s_waitcnt vmcnt(6)" ::: "memory");
  __syncthreads();
  int cur = 0;
#pragma unroll 1
  for (int kt = 0; kt < nk; kt++) {
    const bool more = (kt + 2 < nk);
    int nx = cur + 2; nx = nx >= 3 ? nx - 3 : nx;
    if (more) stage(nx, (kt + 2) << 5);
    compute(cur);
    if (more) asm volatile("s_waitcnt vmcnt(6)" ::: "memory");
    else asm volatile("s_waitcnt vmcnt(0)" ::: "memory");
    __syncthreads();
    cur = cur == 2 ? 0 : cur + 1;
  }
  epi(acc, wm, wn, lane, smem);
}

#define CROW(wm, i, reg, lane) ((wm) * 128 + (i) * 32 + ((reg) & 3) + 8 * ((reg) >> 2) + 4 * ((lane) >> 5))
#define CCOL(wn, j, lane) ((wn) * 64 + (j) * 32 + ((lane) & 31))

__device__ __forceinline__ bool tile_swizzle(int r, int MT8  , int NT, int& m, int& n) {
  const int bid = blockIdx.x, G = gridDim.x;
  const int per = G >> 3;
  const int total = MT8 * NT;
  const int full = total / G;
  int q;
  if (r < full && (G & 7) == 0) q = (r * 8 + (bid & 7)) * per + (bid >> 3);
  else if (r <= full) q = r * G + bid;
  else return false;
  q = __builtin_amdgcn_readfirstlane(q);
  if (q >= total) return false;
  const int sr = q / (8 * NT);
  const int rem = q - sr * 8 * NT;
  n = rem >> 3;
  m = sr * 8 + (rem & 7);
  return true;
}

struct ARowPlain {
  int ld;
  __device__ __forceinline__ int operator()(int i) const { return i * ld; }
};
struct BRowClamp {
  int ld; int n0; int N;
  __device__ __forceinline__ int operator()(int j) const { int n = n0 + j; n = n < N ? n : N - 1; return n * ld; }
};
struct EpiStoreU {
  bf16_t* u; int m0; int n0; int N;
  __device__ __forceinline__ void operator()(f16v (&acc)[4][2], int wm, int wn, int lane, unsigned char*) {
#pragma unroll
    for (int i = 0; i < 4; i++)
#pragma unroll
      for (int j = 0; j < 2; j++) {
        const int col = n0 + CCOL(wn, j, lane);
        if (col < N) {
#pragma unroll
          for (int r = 0; r < 16; r += 2) {
            const int row = m0 + CROW(wm, i, r, lane);
            const unsigned pk = pack2(acc[i][j][r], acc[i][j][r + 1]);
            u[(unsigned)row * UST + col] = (bf16_t)(pk & 0xffffu);
            u[(unsigned)(row + 1) * UST + col] = (bf16_t)(pk >> 16);
          }
        }
      }
  }
};
struct EpiResid {
  const float* xp; const float* xs; bool from_input; float* out; const float* gate;   int m0; int n0;
  __device__ __forceinline__ void operator()(f16v (&acc)[4][2], int wm, int wn, int lane, unsigned char*) {
    const float* g = gate + condof(m0) * 6144;
    const float* rsrc = from_input ? ((m0 < NPTOK) ? xp : (xs - (size_t)NPTOK * 1024)) : (const float*)out;
    const int col0 = n0 + CCOL(wn, 0, lane), col1 = n0 + CCOL(wn, 1, lane);
    const float gv0 = g[col0], gv1 = g[col1];
#pragma unroll
    for (int i = 0; i < 4; i++) {
      float res0[16], res1[16];
#pragma unroll
      for (int r = 0; r < 16; r++) {
        const unsigned ro = (unsigned)(m0 + CROW(wm, i, r, lane)) * 1024;
        res0[r] = rsrc[ro + col0];
        res1[r] = rsrc[ro + col1];
      }
#pragma unroll
      for (int r = 0; r < 16; r++) {
        const unsigned ro = (unsigned)(m0 + CROW(wm, i, r, lane)) * 1024;
        out[ro + col0] = res0[r] + gv0 * acc[i][0][r];
        out[ro + col1] = res1[r] + gv1 * acc[i][1][r];
      }
    }
  }
};
struct ARowHalo {
  int t0; int lo; int hi;
  __device__ __forceinline__ int operator()(int i) const { int t = t0 + i; return (t >= lo && t < hi) ? t * 1024 : -1; }
};
struct BRowUp {
  int n0;
  __device__ __forceinline__ int operator()(int j) const { int n = (j < 64) ? (n0 + j) : (FFN + n0 + j - 64); return n * 1024; }
};
struct EpiConv {
  bf16_t* act; const float* cw; const float* cb; int t0; int hi; int n0; bool halo;
  __device__ __forceinline__ void operator()(f16v (&acc)[4][2], int wm, int wn, int lane, unsigned char* smem) {
    bf16_t* sC = (bf16_t*)smem;
#pragma unroll
    for (int i = 0; i < 4; i++)
#pragma unroll
      for (int j = 0; j < 2; j++)
#pragma unroll
        for (int r = 0; r < 16; r += 2) {
          const unsigned pk = pack2(acc[i][j][r], acc[i][j][r + 1]);
          sC[CROW(wm, i, r, lane) * 136 + CCOL(wn, j, lane)] = (bf16_t)(pk & 0xffffu);
          sC[(CROW(wm, i, r, lane) + 1) * 136 + CCOL(wn, j, lane)] = (bf16_t)(pk >> 16);
        }
    __syncthreads();
    const int tid = opaque_tid() & 255;
    const int cp = tid & 31, rg = tid >> 5;
    const int ca = n0 + 2 * cp, cbi = FFN + n0 + 2 * cp;
    const float2 wa0 = *(const float2*)(cw + ca), wa1 = *(const float2*)(cw + 2 * FFN + ca), wa2 = *(const float2*)(cw + 4 * FFN + ca), ba = *(const float2*)(cb + ca);
    const float2 wb0 = *(const float2*)(cw + cbi), wb1 = *(const float2*)(cw + 2 * FFN + cbi), wb2 = *(const float2*)(cw + 4 * FFN + cbi), bb = *(const float2*)(cb + cbi);
    const int first = halo ? 1 : 0, last = halo ? 254 : 255;
    int ilo = 32 * rg, ihi = 32 * rg + 31;
    ilo = ilo < first ? first : ilo;
    ihi = ihi > last ? last : ihi;
    const bf16_t* sa = sC + 2 * cp;
    const bf16_t* sb = sC + 64 + 2 * cp;
    unsigned ap = ilo > 0 ? *(const unsigned*)(sa + (ilo - 1) * 136) : 0u, ac = *(const unsigned*)(sa + ilo * 136);
    unsigned bp = ilo > 0 ? *(const unsigned*)(sb + (ilo - 1) * 136) : 0u, bc = *(const unsigned*)(sb + ilo * 136);
    for (int i = ilo; i <= ihi; i++) {
      const unsigned an = i < 255 ? *(const unsigned*)(sa + (i + 1) * 136) : 0u;
      const unsigned bn = i < 255 ? *(const unsigned*)(sb + (i + 1) * 136) : 0u;
      const int tok = t0 + i;
      if (tok < hi) {
        const float a0 = ba.x + wa0.x * bflo(ap) + wa1.x * bflo(ac) + wa2.x * bflo(an);
        const float a1 = ba.y + wa0.y * bfhi(ap) + wa1.y * bfhi(ac) + wa2.y * bfhi(an);
        const float b0 = bb.x + wb0.x * bflo(bp) + wb1.x * bflo(bc) + wb2.x * bflo(bn);
        const float b1 = bb.y + wb0.y * bfhi(bp) + wb1.y * bfhi(bc) + wb2.y * bfhi(bn);
        *(unsigned*)(act + (unsigned)tok * FFN + n0 + 2 * cp) = pack2(siluf(a0) * b0, siluf(a1) * b1);
      }
      ap = ac; ac = an; bp = bc; bc = bn;
    }
    __syncthreads();
  }
};

__device__ __forceinline__ void attn_item(const Params& p, int item, unsigned char* smem) {
  bf16_t* sQ = (bf16_t*)smem;
  bf16_t* sK = sQ + 64 * 72;
  bf16_t* sVt = sK + 64 * 72;
  bf16_t* sP = sVt + 64 * 72;
  const bf16_t* u = (const bf16_t*)(p.ws + OFF_U);
  bf16_t* hb = (bf16_t*)(p.ws + OFF_H);
  const int tid = opaque_tid(), lane = tid & 63, w = tid >> 6;
  const bool latent = item >= 1024;
  int tq0, h, nkt, seq = 0, qt = 0, b = 0, r = 0, rs = 0;
  if (!latent) {
    seq = item >> 5; h = (item >> 2) & 7; qt = item & 3;
    tq0 = seq * 256 + qt * 64; nkt = 4;
  } else {
    const int it = item - 1024;
    b = it >> 9; h = (it >> 6) & 7; r = it & 63;
    tq0 = NPTOK + b * 4096 + r * 64; nkt = 12;
    rs = r - 4; rs = rs < 0 ? 0 : (rs > 56 ? 56 : rs);
  }
  const int lrow = tid >> 2, lq = tid & 3;
  __syncthreads();
  {
    const bf16_t* src = u + (unsigned)(tq0 + lrow) * UST + 1296 + h * 64 + lq * 16;
    float f[16];
    unpack8(*(const uint4*)src, f);
    unpack8(*(const uint4*)(src + 8), f + 8);
    float ss = 0.f;
#pragma unroll
    for (int j = 0; j < 16; j++) ss += f[j] * f[j];
    ss = quad_sum(ss);
    const float sc = rsqrtf(ss * (1.f / 64.f) + EPSV) * 0.125f;
    const float* qn = p.in[I_QN] + lq * 16;
#pragma unroll
    for (int j = 0; j < 16; j++) f[j] = f[j] * sc * qn[j];
    *(uint4*)(sQ + lrow * 72 + lq * 16) = pack8(f);
    *(uint4*)(sQ + lrow * 72 + lq * 16 + 8) = pack8(f + 8);
  }
  f4v o[4];
#pragma unroll
  for (int d = 0; d < 4; d++) o[d] = (f4v){0.f, 0.f, 0.f, 0.f};
  float m_run[4] = {-1e30f, -1e30f, -1e30f, -1e30f};
  float l_run[4] = {0.f, 0.f, 0.f, 0.f};
  float* sRPB = (float*)(smem + 4 * 64 * 72 * 2);
  if (latent) {
    const float r0 = p.in[I_RPB][h * 15 * 31 + tid];
    const float r1 = (tid + 256 < 15 * 31) ? p.in[I_RPB][h * 15 * 31 + tid + 256] : 0.f;
    sRPB[tid] = r0;
    if (tid + 256 < 15 * 31) sRPB[tid + 256] = r1;
  }
  float knr[16];
#pragma unroll
  for (int j = 0; j < 16; j++) knr[j] = p.in[I_KN][lq * 16 + j];

  const bf16_t* ckb = (const bf16_t*)(p.ws + OFF_CKB);
  const bf16_t* cvb = (const bf16_t*)(p.ws + OFF_CVB);
  auto tile_ptrs = [&](int kt, const bf16_t*& kp, const bf16_t*& vp) __attribute__((always_inline)) {
    if (latent && kt >= 8) {
      const size_t cb = ((size_t)(b * 8 + h) * 256 + (kt - 8) * 64 + lrow) * 64 + lq * 16;
      kp = ckb + cb; vp = cvb + cb;
    } else {
      const int tk0 = latent ? (NPTOK + b * 4096 + (rs + kt) * 64) : (seq * 256 + kt * 64);
      kp = u + (unsigned)(tk0 + lrow) * UST + 1296 + 512 + h * 64 + lq * 16;
      vp = kp + 512;
    }
  };
  uint4 kr0, kr1, vr0, vr1;
  {
    const bf16_t *kp, *vp;
    tile_ptrs(0, kp, vp);
    kr0 = *(const uint4*)kp; kr1 = *(const uint4*)(kp + 8);
    vr0 = *(const uint4*)vp; vr1 = *(const uint4*)(vp + 8);
  }
  for (int kt = 0; kt < nkt; kt++) {
    __syncthreads();
    const bool from_cache = latent && kt >= 8;
    {
      float f[16];
      unpack8(kr0, f); unpack8(kr1, f + 8);
      bf16_t vh[16];
      halves8(vr0, vh); halves8(vr1, vh + 8);
      const uint4 vs0 = vr0, vs1 = vr1;
      if (kt + 1 < nkt) {
        const bf16_t *kp, *vp;
        tile_ptrs(kt + 1, kp, vp);
        kr0 = *(const uint4*)kp; kr1 = *(const uint4*)(kp + 8);
        vr0 = *(const uint4*)vp; vr1 = *(const uint4*)(vp + 8);
      }
      if (!from_cache) {
        float ss = 0.f;
#pragma unroll
        for (int j = 0; j < 16; j++) ss += f[j] * f[j];
        ss = quad_sum(ss);
        const float sc = rsqrtf(ss * (1.f / 64.f) + EPSV);
#pragma unroll
        for (int j = 0; j < 16; j++) f[j] = f[j] * sc * knr[j];
      }
      *(uint4*)(sK + lrow * 72 + lq * 16) = pack8(f);
      *(uint4*)(sK + lrow * 72 + lq * 16 + 8) = pack8(f + 8);
#pragma unroll
      for (int j = 0; j < 16; j++) sVt[(lq * 16 + j) * 72 + lrow] = vh[j];
      if (!latent && kt == qt) {
        float g[16];
        unpack8(vs0, g); unpack8(vs1, g + 8);
        float* ok = p.out + OUT_NAK + ((unsigned)(seq * 8 + h) * 256 + kt * 64 + lrow) * 64 + lq * 16;
        float* ov = p.out + OUT_NAV + ((unsigned)(seq * 8 + h) * 256 + kt * 64 + lrow) * 64 + lq * 16;
#pragma unroll
        for (int j = 0; j < 16; j += 4) {
          *(float4*)(ok + j) = make_float4(f[j], f[j + 1], f[j + 2], f[j + 3]);
          *(float4*)(ov + j) = make_float4(g[j], g[j + 1], g[j + 2], g[j + 3]);
        }
      }
    }
    __syncthreads();
    f4v s[4];
    {
      const bf16_t* qa = sQ + (16 * w + (lane & 15)) * 72 + (lane >> 4) * 8;
      const s8v a0 = *(const s8v*)(qa);
      const s8v a1 = *(const s8v*)(qa + 32);
#pragma unroll
      for (int nt = 0; nt < 4; nt++) {
        const bf16_t* kb = sK + (nt * 16 + (lane & 15)) * 72 + (lane >> 4) * 8;
        f4v z = (f4v){0.f, 0.f, 0.f, 0.f};
        z = MFMA16(a0, *(const s8v*)(kb), z);
        z = MFMA16(a1, *(const s8v*)(kb + 32), z);
        s[nt] = z;
      }
    }
    if (latent && kt < 8) {
      const int drow = (rs + kt) - r + 7;
      const float* rp = sRPB + drow * 31;
#pragma unroll
      for (int nt = 0; nt < 4; nt++)
#pragma unroll
        for (int rr = 0; rr < 4; rr++) {
          const int cq = 16 * w + (lane >> 4) * 4 + rr;
          const int ck = nt * 16 + (lane & 15);
          int cs = cq - 8; cs = cs < 0 ? 0 : (cs > 48 ? 48 : cs);
          const bool valid = (ck >= cs) && (ck < cs + 16);
          const int dc = valid ? (ck - cq + 15) : 15;
          s[nt][rr] = valid ? (s[nt][rr] + rp[dc]) : -1e30f;
        }
    }
#pragma unroll
    for (int rr = 0; rr < 4; rr++) {
      float mx = fmaxf(fmaxf(s[0][rr], s[1][rr]), fmaxf(s[2][rr], s[3][rr]));
      mx = red16_max(mx);
      const float mn = fmaxf(m_run[rr], mx);
      const float alpha = __expf(m_run[rr] - mn);
      m_run[rr] = mn;
      float lp = 0.f;
      bf16_t* pr = sP + (16 * w + (lane >> 4) * 4 + rr) * 72 + (lane & 15);
      {
        const float p0 = __expf(s[0][rr] - mn), p1 = __expf(s[1][rr] - mn), p2 = __expf(s[2][rr] - mn), p3 = __expf(s[3][rr] - mn);
        lp = (p0 + p1) + (p2 + p3);
        const unsigned k01 = pack2(p0, p1), k23 = pack2(p2, p3);
        pr[0] = (bf16_t)(k01 & 0xffffu); pr[16] = (bf16_t)(k01 >> 16);
        pr[32] = (bf16_t)(k23 & 0xffffu); pr[48] = (bf16_t)(k23 >> 16);
      }
      l_run[rr] = l_run[rr] * alpha + lp;
#pragma unroll
      for (int d = 0; d < 4; d++) o[d][rr] *= alpha;
    }
    __syncthreads();
    {
      const bf16_t* pa = sP + (16 * w + (lane & 15)) * 72 + (lane >> 4) * 8;
      const s8v a0 = *(const s8v*)(pa);
      const s8v a1 = *(const s8v*)(pa + 32);
#pragma unroll
      for (int d = 0; d < 4; d++) {
        const bf16_t* vb = sVt + (d * 16 + (lane & 15)) * 72 + (lane >> 4) * 8;
        o[d] = MFMA16(a0, *(const s8v*)(vb), o[d]);
        o[d] = MFMA16(a1, *(const s8v*)(vb + 32), o[d]);
      }
    }
  }
#pragma unroll
  for (int rr = 0; rr < 4; rr++) {
    float l = l_run[rr];
    l = red16_sum(l);
    const float inv = __builtin_amdgcn_rcpf(l);
    const int tok = tq0 + 16 * w + (lane >> 4) * 4 + rr;
#pragma unroll
    for (int d = 0; d < 4; d++) hb[(unsigned)tok * 1024 + 512 + h * 64 + d * 16 + (lane & 15)] = f2bf(o[d][rr] * inv);
  }
}

#define SC_G 0
#define SC_PS 8192
#define SC_EGL 9216
#define SC_GS 9472
#define SC_RS 9600
#define SC_QS 10112
#define SC_QI 14720
#define SC_KS 19328
#define SC_KET 23936
#define SC_VT 29056
#define SC_P 39296
#define SC_ST 41856
#define SC_XH 60288
#define SC_WA 64896

template <int KIND, int DV>
__device__ __forceinline__ void scan_run(const Params& p, int seg, int hh, int dir, int mode, f4v (&S)[4][DV / 64], unsigned char* smem) {
  constexpr int NCT = DV / 64;
  constexpr int WDV = DV / 4;
  float* sG = (float*)(smem + SC_G);
  float* sPS = (float*)(smem + SC_PS);
  float* sEGL = (float*)(smem + SC_EGL);
  float* sGS = (float*)(smem + SC_GS);
  float* sRS = (float*)(smem + SC_RS);
  bf16_t* sQS = (bf16_t*)(smem + SC_QS);
  bf16_t* sQI = (bf16_t*)(smem + SC_QI);
  bf16_t* sKS = (bf16_t*)(smem + SC_KS);
  bf16_t* sKET = (bf16_t*)(smem + SC_KET);
  bf16_t* sVT = (bf16_t*)(smem + SC_VT);
  bf16_t* sP = (bf16_t*)(smem + SC_P);
  bf16_t* sST = (bf16_t*)(smem + SC_ST);
  bf16_t* sXH = (bf16_t*)(smem + SC_XH);
  float* sWA = (float*)(smem + SC_WA);
  bf16_t* u = (bf16_t*)(p.ws + OFF_U);
  bf16_t* hb = (bf16_t*)(p.ws + OFF_H);
  const int tid = opaque_tid(), lane = tid & 63, w = tid >> 6;
  const int li = tid >> 3, dg = tid & 7;
  const int tb = seg * 256;
  const bool prompt = seg < 32;

  __syncthreads();
  if (KIND == 1) {
    const float* wa = p.in[I_WA2] + dir * 16 * 256 + hh * 64;
    float t4[4];
#pragma unroll
    for (int i = 0; i < 4; i++) t4[i] = wa[((tid + 256 * i) >> 6) * 256 + ((tid + 256 * i) & 63)];
#pragma unroll
    for (int i = 0; i < 4; i++) sWA[tid + 256 * i] = t4[i];
  } else if (KIND == 2) {
    const float* lb = (const float*)(p.ws + OFF_LB) + dir * 256 + hh * 64;
    if (tid < 64) sWA[tid] = lb[tid];
  } else {
    float t3[3];
#pragma unroll
    for (int b3 = 0; b3 < 3; b3++) {
      const int i = tid + 256 * b3;
      const int blk = i >> 8, tap = (i >> 6) & 3, d = i & 63;
      const int ch = (blk == 0 ? 512 + (hh >> 2) * 64 : (blk == 1 ? 640 + (hh >> 2) * 64 : hh * 64)) + d;
      const float* srcp = tap < 3 ? (p.in[I_SCW] + tap * 768 + ch) : (p.in[I_SCB] + ch);
      t3[b3] = *srcp;
    }
#pragma unroll
    for (int b3 = 0; b3 < 3; b3++) sWA[tid + 256 * b3] = t3[b3];
  }
  float gtot[8];
#pragma unroll
  for (int j = 0; j < 8; j++) gtot[j] = 0.f;
  float bar[8];
#pragma unroll
  for (int j = 0; j < 8; j++) bar[j] = (KIND == 1) ? p.in[I_BA2][dir * 256 + hh * 64 + dg * 8 + j] : 0.f;
  float nwr[NCT];
#pragma unroll
  for (int ct = 0; ct < NCT; ct++) nwr[ct] = (KIND == 0) ? 0.f : ((KIND == 1) ? p.in[I_GLANW] : p.in[I_HGNW])[w * WDV + ct * 16 + (lane & 15)];
  float dtb = 0.f, aneg = 0.f, dsk = 0.f;
  if (KIND == 0) {
    dtb = p.in[I_DTB][dir * 8 + hh];
    aneg = -__expf(p.in[I_ALOG][dir * 8 + hh]);
    dsk = p.in[I_SSDD][hh];
  }
  __syncthreads();

  for (int c = 0; c < 8; c++) {
    if (mode != 0) {
#pragma unroll
      for (int kt = 0; kt < 4; kt++)
#pragma unroll
        for (int ct = 0; ct < NCT; ct++) {
          uint2 pk;
          pk.x = pack2(S[kt][ct][0], S[kt][ct][1]);
          pk.y = pack2(S[kt][ct][2], S[kt][ct][3]);
          *(uint2*)(sST + (w * WDV + ct * 16 + (lane & 15)) * 72 + kt * 16 + (lane >> 4) * 4) = pk;
        }
    }
    uint4 ofv0 = make_uint4(0, 0, 0, 0), ofv1 = make_uint4(0, 0, 0, 0);
    if (mode == 2) {
      const int tm = w * 64 + (3 - (lane >> 4)) * 16 + (lane & 15);
      const int tokm = tb + (7 - c) * 32 + (tm >> 3);
      const bf16_t* srcv = (KIND == 0) ? (u + (unsigned)tokm * UST + 2832 + hh * 64 + (tm & 7) * 8)
                                       : (hb + (unsigned)tokm * 1024 + (KIND - 1) * 512 + hh * 128 + (tm & 7) * 16);
      ofv0 = *(const uint4*)srcv;
      if (NCT == 2) ofv1 = *(const uint4*)(srcv + 8);
    }
    const int lidx = c * 32 + li;
    const int tok = tb + (dir ? (255 - lidx) : lidx);
    float q[8] = {0.f, 0.f, 0.f, 0.f, 0.f, 0.f, 0.f, 0.f}, k[8], g[8];
    if (KIND == 0) {
      const int pos = prompt ? (tok & 255) : (tok & 4095);
      const int T = prompt ? 256 : 4096;
      const bool hp = pos > 0, hn = pos < T - 1;
      const bf16_t* ur = u + (unsigned)tok * UST;
      const float dt_raw = bf2f(ur[1280 + dir * 8 + hh]) + dtb;
      const float dt = dt_raw > 20.f ? dt_raw : __logf(1.f + __expf(dt_raw));
      const float gg = aneg * dt;
#pragma unroll
      for (int j = 0; j < 8; j++) g[j] = gg;
      const int grp = hh >> 2;
      const uint4 z4 = make_uint4(0, 0, 0, 0);
      {
        const int col = 1024 + grp * 64 + dg * 8;
        float x0[8], x1[8], x2[8];
        unpack8(hp ? *(const uint4*)(ur - UST + col) : z4, x0);
        unpack8(*(const uint4*)(ur + col), x1);
        unpack8(hn ? *(const uint4*)(ur + UST + col) : z4, x2);
        const float* cw = sWA + 0 + dg * 8;
#pragma unroll
        for (int j = 0; j < 8; j++) k[j] = siluf(cw[192 + j] + cw[j] * x0[j] + cw[64 + j] * x1[j] + cw[128 + j] * x2[j]);
      }
      __builtin_amdgcn_sched_barrier(0);
      if (mode != 0) {
        const int col = 1152 + grp * 64 + dg * 8;
        float x0[8], x1[8], x2[8];
        unpack8(hp ? *(const uint4*)(ur - UST + col) : z4, x0);
        unpack8(*(const uint4*)(ur + col), x1);
        unpack8(hn ? *(const uint4*)(ur + UST + col) : z4, x2);
        const float* cw = sWA + 256 + dg * 8;
#pragma unroll
        for (int j = 0; j < 8; j++) q[j] = siluf(cw[192 + j] + cw[j] * x0[j] + cw[64 + j] * x1[j] + cw[128 + j] * x2[j]);
      }
      __builtin_amdgcn_sched_barrier(0);
      {
        const int col = 512 + hh * 64 + dg * 8;
        float x0[8], x1[8], x2[8];
        unpack8(hp ? *(const uint4*)(ur - UST + col) : z4, x0);
        unpack8(*(const uint4*)(ur + col), x1);
        unpack8(hn ? *(const uint4*)(ur + UST + col) : z4, x2);
        const float* cw = sWA + 512 + dg * 8;
        float xh[8];
#pragma unroll
        for (int j = 0; j < 8; j++) {
          xh[j] = siluf(cw[192 + j] + cw[j] * x0[j] + cw[64 + j] * x1[j] + cw[128 + j] * x2[j]);
          sVT[(dg * 8 + j) * 40 + li] = f2bf(xh[j] * dt);
        }
        if (mode == 2) *(uint4*)(sXH + li * 72 + dg * 8) = pack8(xh);
      }
    } else if (KIND == 1) {
      const bf16_t* ur = u + (unsigned)tok * UST;
      unpack8(*(const uint4*)(ur + hh * 64 + dg * 8), q);
      unpack8(*(const uint4*)(ur + 256 + hh * 64 + dg * 8), k);
#pragma unroll
      for (int j = 0; j < 8; j++) q[j] *= 0.125f;
      float ga[16];
      unpack8(*(const uint4*)(ur + 1536 + dir * 16), ga);
      unpack8(*(const uint4*)(ur + 1536 + dir * 16 + 8), ga + 8);
      float x[8];
#pragma unroll
      for (int j = 0; j < 8; j++) x[j] = bar[j];
#pragma unroll
      for (int rr = 0; rr < 16; rr++) {
        const float4 w0 = *(const float4*)(sWA + rr * 64 + dg * 8);
        const float4 w1 = *(const float4*)(sWA + rr * 64 + dg * 8 + 4);
        x[0] += ga[rr] * w0.x; x[1] += ga[rr] * w0.y; x[2] += ga[rr] * w0.z; x[3] += ga[rr] * w0.w;
        x[4] += ga[rr] * w1.x; x[5] += ga[rr] * w1.y; x[6] += ga[rr] * w1.z; x[7] += ga[rr] * w1.w;
      }
#pragma unroll
      for (int j = 0; j < 8; j++) g[j] = (fminf(x[j], 0.f) - __logf(1.f + __expf(-fabsf(x[j])))) * (1.f / 16.f);
      const bf16_t* vs = ur + 512 + hh * 128 + dg * 16;
      bf16_t vh[16];
      halves8(*(const uint4*)vs, vh);
      halves8(*(const uint4*)(vs + 8), vh + 8);
#pragma unroll
      for (int j = 0; j < 16; j++) sVT[(dg * 16 + j) * 40 + li] = vh[j];
    } else {
      const bf16_t* ur = u + (unsigned)tok * UST;
      unpack8(*(const uint4*)(ur + 1568 + hh * 64 + dg * 8), q);
      float fr[8];
      unpack8(*(const uint4*)(ur + 1824 + dir * 256 + hh * 64 + dg * 8), fr);
#pragma unroll
      for (int j = 0; j < 8; j++) {
        const float lbv = sWA[dg * 8 + j];
        const float f = lbv + (1.f - lbv) * sigmf(fr[j]);
        k[j] = 1.f - f;
        g[j] = __logf(f);
      }
      const bf16_t* vs = ur + 2336 + hh * 128 + dg * 16;
      bf16_t vh[16];
      halves8(*(const uint4*)vs, vh);
      halves8(*(const uint4*)(vs + 8), vh + 8);
#pragma unroll
      for (int j = 0; j < 16; j++) sVT[(dg * 16 + j) * 40 + li] = vh[j];
    }
    *(float4*)(sG + li * 64 + dg * 8) = make_float4(g[0], g[1], g[2], g[3]);
    *(float4*)(sG + li * 64 + dg * 8 + 4) = make_float4(g[4], g[5], g[6], g[7]);
    __syncthreads();
    {
      const int d = tid & 63, part = tid >> 6;
      float gv[8];
#pragma unroll
      for (int rr = 0; rr < 8; rr++) gv[rr] = sG[(part * 8 + rr) * 64 + d];
      float a = 0.f;
#pragma unroll
      for (int rr = 0; rr < 8; rr++) {
        a += gv[rr];
        sG[(part * 8 + rr) * 64 + d] = a;
      }
      sPS[part * 64 + d] = a;
    }
    __syncthreads();
    {
      float Gv[8], Gl[8];
      const float4 g0 = *(const float4*)(sG + li * 64 + dg * 8);
      const float4 g1 = *(const float4*)(sG + li * 64 + dg * 8 + 4);
      Gv[0] = g0.x; Gv[1] = g0.y; Gv[2] = g0.z; Gv[3] = g0.w; Gv[4] = g1.x; Gv[5] = g1.y; Gv[6] = g1.z; Gv[7] = g1.w;
      const int part = __builtin_amdgcn_readfirstlane(li >> 3);
#pragma unroll
      for (int j = 0; j < 8; j++) {
        const float p0 = sPS[dg * 8 + j], p1 = sPS[64 + dg * 8 + j], p2 = sPS[128 + dg * 8 + j], p3 = sPS[192 + dg * 8 + j];
        Gl[j] = p0 + p1 + p2 + p3;
        Gv[j] += (part > 0 ? p0 : 0.f) + (part > 1 ? p1 : 0.f) + (part > 2 ? p2 : 0.f);
      }
      float t[8];
#pragma unroll
      for (int j = 0; j < 8; j++) t[j] = k[j] * __expf(Gl[j] - Gv[j]);
#pragma unroll
      for (int j = 0; j < 8; j += 2) {
        const unsigned pk = pack2(t[j], t[j + 1]);
        sKET[(dg * 8 + j) * 40 + li] = (bf16_t)(pk & 0xffffu);
        sKET[(dg * 8 + j + 1) * 40 + li] = (bf16_t)(pk >> 16);
      }
      if (li == 0) {
#pragma unroll
        for (int j = 0; j < 8; j++) { sEGL[dg * 8 + j] = __expf(Gl[j]); gtot[j] += Gl[j]; }
      }
      if (mode != 0) {
        if (KIND == 0) {
          *(uint4*)(sQS + li * 72 + dg * 8) = pack8(q);
          *(uint4*)(sKS + li * 72 + dg * 8) = pack8(k);
#pragma unroll
          for (int j = 0; j < 8; j++) t[j] = q[j] * __expf(Gv[j]);
          *(uint4*)(sQI + li * 72 + dg * 8) = pack8(t);
          if (dg == 0) sGS[li] = Gv[0];
        } else {
#pragma unroll
          for (int j = 0; j < 8; j++) t[j] = q[j] * __expf(Gv[j]);
          const uint4 pq = pack8(t);
          *(uint4*)(sQS + li * 72 + dg * 8) = pq;
          *(uint4*)(sQI + li * 72 + dg * 8) = pq;
#pragma unroll
          for (int j = 0; j < 8; j++) t[j] = k[j] * __expf(-Gv[j]);
          *(uint4*)(sKS + li * 72 + dg * 8) = pack8(t);
        }
      }
    }
    __syncthreads();
    if (mode != 0) {
      const int ti = w >> 1, si = w & 1;
      const bf16_t* qa = sQS + (ti * 16 + (lane & 15)) * 72 + (lane >> 4) * 8;
      const bf16_t* kb = sKS + (si * 16 + (lane & 15)) * 72 + (lane >> 4) * 8;
      f4v z = (f4v){0.f, 0.f, 0.f, 0.f};
      z = MFMA16(*(const s8v*)(qa), *(const s8v*)(kb), z);
      z = MFMA16(*(const s8v*)(qa + 32), *(const s8v*)(kb + 32), z);
      const int scol = si * 16 + (lane & 15);
#pragma unroll
      for (int rr = 0; rr < 4; rr++) {
        const int trow = ti * 16 + (lane >> 4) * 4 + rr;
        float v = z[rr];
        if (KIND == 0) {
          const float df = sGS[trow] - sGS[scol];
          v *= __expf(fminf(df, 0.f));
        }
        v = (scol <= trow) ? v : 0.f;
        sP[trow * 40 + scol] = f2bf(v);
      }
    }
    __syncthreads();
    f4v o[2][NCT];
    if (mode != 0) {
#pragma unroll
      for (int rt = 0; rt < 2; rt++) {
        const s8v pa = *(const s8v*)(sP + (rt * 16 + (lane & 15)) * 40 + (lane >> 4) * 8);
        const bf16_t* qa = sQI + (rt * 16 + (lane & 15)) * 72 + (lane >> 4) * 8;
        const s8v q0 = *(const s8v*)(qa);
        const s8v q1 = *(const s8v*)(qa + 32);
#pragma unroll
        for (int ct = 0; ct < NCT; ct++) {
          const int vr = w * WDV + ct * 16 + (lane & 15);
          f4v z = (f4v){0.f, 0.f, 0.f, 0.f};
          z = MFMA16(pa, *(const s8v*)(sVT + vr * 40 + (lane >> 4) * 8), z);
          z = MFMA16(q0, *(const s8v*)(sST + vr * 72 + (lane >> 4) * 8), z);
          z = MFMA16(q1, *(const s8v*)(sST + vr * 72 + 32 + (lane >> 4) * 8), z);
          o[rt][ct] = z;
        }
      }
    }
#pragma unroll
    for (int kt = 0; kt < 4; kt++) {
      const s8v ka = *(const s8v*)(sKET + (kt * 16 + (lane & 15)) * 40 + (lane >> 4) * 8);
      const float4 eg = *(const float4*)(sEGL + kt * 16 + (lane >> 4) * 4);
#pragma unroll
      for (int ct = 0; ct < NCT; ct++) {
        const int vr = w * WDV + ct * 16 + (lane & 15);
        f4v z = S[kt][ct];
        z[0] *= eg.x; z[1] *= eg.y; z[2] *= eg.z; z[3] *= eg.w;
        S[kt][ct] = MFMA16(ka, *(const s8v*)(sVT + vr * 40 + (lane >> 4) * 8), z);
      }
    }
    if (mode == 1) {
      float pv[8 * NCT];
#pragma unroll
      for (int rt = 0; rt < 2; rt++)
#pragma unroll
        for (int rr = 0; rr < 4; rr++)
#pragma unroll
          for (int ct = 0; ct < NCT; ct++) pv[(rt * 4 + rr) * NCT + ct] = o[rt][ct][rr];
      const int tokf = tb + c * 32 + (tid >> 3);
      bf16_t* dst = (KIND == 0) ? (u + (unsigned)tokf * UST + 2832 + hh * 64 + (tid & 7) * 8)
                                : (hb + (unsigned)tokf * 1024 + (KIND - 1) * 512 + hh * 128 + (tid & 7) * 16);
      *(uint4*)dst = pack8(pv);
      if (NCT == 2) *(uint4*)(dst + 8) = pack8(pv + 8 * (NCT - 1));
    } else if (mode == 2) {
      float tot[2][NCT][4];
      float ssq[2][4];
      {
        float fv[8 * NCT];
        unpack8(ofv0, fv);
        if (NCT == 2) unpack8(ofv1, fv + 8 * (NCT - 1));
#pragma unroll
        for (int rt = 0; rt < 2; rt++)
#pragma unroll
          for (int rr = 0; rr < 4; rr++)
#pragma unroll
            for (int ct = 0; ct < NCT; ct++) tot[rt][ct][rr] = fv[((1 - rt) * 4 + (3 - rr)) * NCT + ct];
      }
      float gat[2][NCT][4];
      if (KIND != 0) {
        const int gcol = (KIND == 1) ? 1024 : 2848;
#pragma unroll
        for (int rt = 0; rt < 2; rt++)
#pragma unroll
          for (int rr = 0; rr < 4; rr++) {
            const int i = rt * 16 + (lane >> 4) * 4 + rr;
            const int li2 = c * 32 + i;
            const int tk = tb + (dir ? (255 - li2) : li2);
#pragma unroll
            for (int ct = 0; ct < NCT; ct++)
              gat[rt][ct][rr] = bf2f(u[(unsigned)tk * UST + gcol + hh * 128 + w * WDV + ct * 16 + (lane & 15)]);
          }
      }
#pragma unroll
      for (int rt = 0; rt < 2; rt++)
#pragma unroll
        for (int rr = 0; rr < 4; rr++) {
          const int i = rt * 16 + (lane >> 4) * 4 + rr;
          const int li2 = c * 32 + i;
          const int tk = tb + (dir ? (255 - li2) : li2);
          float sq = 0.f;
#pragma unroll
          for (int ct = 0; ct < NCT; ct++) {
            const int pc = w * WDV + ct * 16 + (lane & 15);
            float tv = o[rt][ct][rr] + tot[rt][ct][rr];
            if (KIND == 0) {
              tv += dsk * bf2f(sXH[i * 72 + pc]);
              u[(unsigned)tk * UST + 2832 + hh * 64 + pc] = f2bf(tv);
            }
            tot[rt][ct][rr] = tv;
            sq += tv * tv;
          }
          ssq[rt][rr] = sq;
        }
      if (KIND != 0) {
#pragma unroll
        for (int rt = 0; rt < 2; rt++)
#pragma unroll
          for (int rr = 0; rr < 4; rr++) {
            float sq = ssq[rt][rr];
            sq = red16_sum(sq);
            if ((lane & 15) == 0) sRS[w * 32 + rt * 16 + (lane >> 4) * 4 + rr] = sq;
          }
        __syncthreads();
#pragma unroll
        for (int rt = 0; rt < 2; rt++)
#pragma unroll
          for (int rr = 0; rr < 4; rr++) {
            const int i = rt * 16 + (lane >> 4) * 4 + rr;
            const int li2 = c * 32 + i;
            const int tk = tb + (dir ? (255 - li2) : li2);
            const float sq = sRS[i] + sRS[32 + i] + sRS[64 + i] + sRS[96 + i];
            const float scl = rsqrtf(sq * (1.f / 128.f) + EPSV);
#pragma unroll
            for (int ct = 0; ct < NCT; ct++) {
              const int pc = w * WDV + ct * 16 + (lane & 15);
              hb[(unsigned)tk * 1024 + (KIND - 1) * 512 + hh * 128 + pc] = f2bf(tot[rt][ct][rr] * scl * nwr[ct] * siluf(gat[rt][ct][rr]));
            }
          }
      }
    }
    __syncthreads();
  }
  if (mode == 0 && li == 0) {
#pragma unroll
    for (int j = 0; j < 8; j++) sEGL[dg * 8 + j] = __expf(gtot[j]);
  }
  __syncthreads();
}

template <int DV>
__device__ __forceinline__ void state_zero(f4v (&S)[4][DV / 64]) {
#pragma unroll
  for (int kt = 0; kt < 4; kt++)
#pragma unroll
    for (int ct = 0; ct < DV / 64; ct++) S[kt][ct] = (f4v){0.f, 0.f, 0.f, 0.f};
}
#define PIN_U4(a) asm volatile("" ::"v"((a).x), "v"((a).y), "v"((a).z), "v"((a).w) : "memory")
template <int DV>
__device__ __forceinline__ void state_load_f32(f4v (&S)[4][DV / 64], const float* src  , unsigned char* smem) {
  const int tid = opaque_tid(), lane = tid & 63, w = tid >> 6;
  float* l = (float*)smem;
  __syncthreads();
  {
    float4 t[DV / 16];
#pragma unroll
    for (int i = 0; i < DV / 16; i++) t[i] = ((const float4*)src)[tid + 256 * i];
#pragma unroll
    for (int i = 0; i < DV / 16; i++) PIN_U4(t[i]);
#pragma unroll
    for (int i = 0; i < DV / 16; i++) ((float4*)l)[tid + 256 * i] = t[i];
  }
  __syncthreads();
  const float* lb = l + ((lane >> 4) * 4) * DV + w * (DV / 4) + (lane & 15);
#pragma unroll
  for (int kt = 0; kt < 4; kt++)
#pragma unroll
    for (int ct = 0; ct < DV / 64; ct++)
#pragma unroll
      for (int r = 0; r < 4; r++) S[kt][ct][r] = lb[(kt * 16 + r) * DV + ct * 16];
}
template <int DV>
__device__ __forceinline__ void state_store_f32(const f4v (&S)[4][DV / 64], float* dst, unsigned char* smem) {
  const int tid = opaque_tid(), lane = tid & 63, w = tid >> 6;
  float* l = (float*)smem;
  __syncthreads();
  float* lb = l + ((lane >> 4) * 4) * DV + w * (DV / 4) + (lane & 15);
#pragma unroll
  for (int kt = 0; kt < 4; kt++)
#pragma unroll
    for (int ct = 0; ct < DV / 64; ct++)
#pragma unroll
      for (int r = 0; r < 4; r++) lb[(kt * 16 + r) * DV + ct * 16] = S[kt][ct][r];
  __syncthreads();
  {
    float4 t[DV / 16];
#pragma unroll
    for (int i = 0; i < DV / 16; i++) t[i] = ((const float4*)l)[tid + 256 * i];
#pragma unroll
    for (int i = 0; i < DV / 16; i++) ((float4*)dst)[tid + 256 * i] = t[i];
  }
}
template <int DV>
__device__ __forceinline__ void state_combine(f4v (&S)[4][DV / 64], const bf16_t* sl, const float* D, unsigned char* smem) {
  const int tid = opaque_tid(), lane = tid & 63, w = tid >> 6;
  bf16_t* l = (bf16_t*)smem;
  float* ld = (float*)(smem + 16384);
  __syncthreads();
  {
    uint4 t[4];
#pragma unroll
    for (int i = 0; i < 4; i++) t[i] = ((const uint4*)sl)[tid + 256 * i];
    const float dv = D[tid & 63];
#pragma unroll
    for (int i = 0; i < 4; i++) PIN_U4(t[i]);
    asm volatile("" ::"v"(dv) : "memory");
#pragma unroll
    for (int i = 0; i < 4; i++) ((uint4*)l)[tid + 256 * i] = t[i];
    if (tid < 64) ld[tid] = dv;
  }
  __syncthreads();
  const bf16_t* lb = l + ((lane >> 4) * 4) * 128 + w * (DV / 4) + (lane & 15);
  const float* ldb = ld + (lane >> 4) * 4;
#pragma unroll
  for (int kt = 0; kt < 4; kt++)
#pragma unroll
    for (int r = 0; r < 4; r++) {
      const float dd = ldb[kt * 16 + r];
#pragma unroll
      for (int ct = 0; ct < DV / 64; ct++) S[kt][ct][r] = S[kt][ct][r] * dd + bf2f(lb[(kt * 16 + r) * 128 + ct * 16]);
    }
}
template <int DV>
__device__ __forceinline__ void state_store_bf16(const f4v (&S)[4][DV / 64], bf16_t* dst, unsigned char* smem) {
  const int tid = opaque_tid(), lane = tid & 63, w = tid >> 6;
  bf16_t* l = (bf16_t*)smem;
  __syncthreads();
  bf16_t* lb = l + ((lane >> 4) * 4) * 128 + w * (DV / 4) + (lane & 15);
#pragma unroll
  for (int kt = 0; kt < 4; kt++)
#pragma unroll
    for (int ct = 0; ct < DV / 64; ct++)
#pragma unroll
      for (int r = 0; r < 4; r++) lb[(kt * 16 + r) * 128 + ct * 16] = f2bf(S[kt][ct][r]);
  __syncthreads();
  {
    uint4 t[4];
#pragma unroll
    for (int i = 0; i < 4; i++) t[i] = ((const uint4*)l)[tid + 256 * i];
#pragma unroll
    for (int i = 0; i < 4; i++) ((uint4*)dst)[tid + 256 * i] = t[i];
  }
}

template <int KIND, int DV>
__device__ __forceinline__ void scan_work(const Params& p, bool local, int seg, int hg, int hh, int ldir, const float* s0f, const float* s0b,
                                          float* outf, float* outb, int nheads, unsigned char* smem) {
  f4v S[4][DV / 64];
  const bf16_t* SL = (const bf16_t*)(p.ws + OFF_SL);
  const float* DL = (const float*)(p.ws + OFF_DL);
  const int npass = local ? 1 : 2;
  for (int pass = 0; pass < npass; pass++) {
    const int mode = local ? 0 : pass + 1;
    const int dir = local ? ldir : pass;
    state_zero<DV>(S);
    if (!local && seg >= 32) {
      const int sq = (seg - 32) >> 4, j = (seg - 32) & 15;
      state_load_f32<DV>(S, (dir ? s0b : s0f) + (unsigned)(sq * nheads + hh) * 64 * DV, smem);
      const int jbeg = dir ? 15 : 0, jstep = dir ? -1 : 1;
      for (int jj = jbeg; jj != j; jj += jstep) {
        const size_t idx = ((size_t)((sq * 16 + jj) * 8 + hg) * 2 + dir);
        state_combine<DV>(S, SL + idx * 8192, DL + idx * 64, smem);
      }
    }
    scan_run<KIND, DV>(p, seg, hh, dir, mode, S, smem);
    if (local) {
      const size_t idx = ((size_t)((seg - 32) * 8 + hg) * 2 + dir);
      if (opaque_tid() < 64) ((float*)(p.ws + OFF_DL))[idx * 64 + opaque_tid()] = ((float*)(smem + SC_EGL))[opaque_tid()];
      state_store_bf16<DV>(S, (bf16_t*)(p.ws + OFF_SL) + idx * 8192, smem);
    } else if (seg < 32) {
      state_store_f32<DV>(S, (dir ? outb : outf) + (unsigned)(seg * nheads + hh) * 64 * DV, smem);
    }
  }
}

__device__ __forceinline__ void ssd_post_phase(const Params& p) {
  const bf16_t* u = (const bf16_t*)(p.ws + OFF_U);
  bf16_t* hb = (bf16_t*)(p.ws + OFF_H);
  const int lane = opaque_tid() & 63, wave = opaque_tid() >> 6;
  const float* nw = p.in[I_SSDNW] + lane * 8;
  float nwv[8];
#pragma unroll
  for (int j = 0; j < 8; j++) nwv[j] = nw[j];
  for (int item = blockIdx.x; item < NTOK / 8; item += gridDim.x) {
    const int row = item * 8 + wave * 2;
    const uint4 ro0 = *(const uint4*)(u + (unsigned)row * UST + 2832 + lane * 8);
    const uint4 rz0 = *(const uint4*)(u + (unsigned)row * UST + lane * 8);
    const uint4 ro1 = *(const uint4*)(u + (unsigned)(row + 1) * UST + 2832 + lane * 8);
    const uint4 rz1 = *(const uint4*)(u + (unsigned)(row + 1) * UST + lane * 8);
    float o0[8], z0[8], o1[8], z1[8];
    unpack8(ro0, o0); unpack8(rz0, z0); unpack8(ro1, o1); unpack8(rz1, z1);
    float ss0 = 0.f, ss1 = 0.f;
#pragma unroll
    for (int j = 0; j < 8; j++) {
      o0[j] = o0[j] * siluf(z0[j]); ss0 += o0[j] * o0[j];
      o1[j] = o1[j] * siluf(z1[j]); ss1 += o1[j] * o1[j];
    }
#pragma unroll
    for (int m = 32; m >= 1; m >>= 1) { ss0 += __shfl_xor(ss0, m); ss1 += __shfl_xor(ss1, m); }
    const float r0 = rsqrtf(ss0 * (1.f / 512.f) + EPSV), r1 = rsqrtf(ss1 * (1.f / 512.f) + EPSV);
#pragma unroll
    for (int j = 0; j < 8; j++) { o0[j] = o0[j] * r0 * nwv[j]; o1[j] = o1[j] * r1 * nwv[j]; }
    *(uint4*)(hb + (unsigned)row * 1024 + lane * 8) = pack8(o0);
    *(uint4*)(hb + (unsigned)(row + 1) * 1024 + lane * 8) = pack8(o1);
  }
}

template <int layer>
__device__ __forceinline__ void layer_body(const Params& p, unsigned char* smem, const XcdBarrier& xb) {
  const int bid = blockIdx.x, nb = gridDim.x;
  bf16_t* Wt_in = (bf16_t*)(p.ws + OFF_WIN);
  bf16_t* Wt_out = (bf16_t*)(p.ws + OFF_WOUT);
  bf16_t* Wt_up = (bf16_t*)(p.ws + OFF_WUP);
  bf16_t* Wt_dn = (bf16_t*)(p.ws + OFF_WDN);
  bf16_t* ub = (bf16_t*)(p.ws + OFF_U);
  bf16_t* hb = (bf16_t*)(p.ws + OFF_H);
  const float* mods = (const float*)(p.ws + OFF_MODS);
  const bf16_t* zrow = (const bf16_t*)(p.ws + OFF_ZROW);
    const float* mods_l = mods + (unsigned)layer * 5 * 6144;
    const int NIN = layer == 0 ? 2832 : 3360;
    normmod_phase(p, layer, 0, layer == 0);
    xcd_barrier(xb);
    {
      const int NT = (NIN + 127) >> 7;
      for (int r = 0;; r++) {
        int mt, nt;
        if (!tile_swizzle(r, 96, NT, mt, nt)) break;
        ARowPlain af{1024};
        BRowClamp bf{1024, nt * 128, NIN};
        EpiStoreU ep{ub, mt * 256, nt * 128, NIN};
        gemm_tile(hb + (unsigned)mt * 256 * 1024, Wt_in, zrow, af, bf, 1024, ep, smem);
      }
    }
    xcd_barrier(xb);
    if (layer == 0) {
      for (int it = bid; it < 3072 + 1024; it += nb) {
        if (it < 2048) attn_item(p, 1024 + it, smem);
        else if (it < 3072) attn_item(p, it - 2048, smem);
        else {
          const int t = it - 3072;
          scan_work<0, 64>(p, true, 32 + (t >> 4), (t >> 1) & 7, (t >> 1) & 7, t & 1, nullptr, nullptr, nullptr, nullptr, 8, smem);
        }
      }
      xcd_barrier(xb);
      for (int it = bid; it < 768; it += nb) {
        const int seg = 95 - (it >> 3), hg = it & 7;
        scan_work<0, 64>(p, false, seg, hg, hg, 0, p.in[I_SSDF], p.in[I_SSDB], p.out + OUT_SSDF, p.out + OUT_SSDB, 8, smem);
      }
      {
        const int idle0 = (768 - nb) > 0 ? (768 - nb) : 0;
        const int n_in = convert_ntiles(1024, 3360), n_up = convert_ntiles(1024, 5632), n_dn = convert_ntiles(2816, 1024);
        if (bid >= idle0)
          for (int it = bid - idle0; it < 384 + n_in + n_up + n_dn; it += nb - idle0) {
            int t = it;
            if (t < 384) { mods_item(p, 384 + t, smem); continue; }
            t -= 384;
            if (t < n_in) { convert_tile(p.in[I_WIN1], Wt_in, 1024, 3360, t, smem); continue; }
            t -= n_in;
            if (t < n_up) { convert_tile(p.in[I_WUP], Wt_up, 1024, 5632, t, smem); continue; }
            t -= n_up;
            convert_tile(p.in[I_WDN], Wt_dn, 2816, 1024, t, smem);
          }
      }
      xcd_barrier(xb);
      ssd_post_phase(p);
      xcd_barrier(xb);
    } else {
      for (int t = bid; t < 1024; t += nb) {
        const int ss = t >> 4, hg = (t >> 1) & 7, dir = t & 1;
        if (hg < 4) scan_work<1, 128>(p, true, 32 + ss, hg, hg, dir, nullptr, nullptr, nullptr, nullptr, 4, smem);
        else scan_work<2, 128>(p, true, 32 + ss, hg, hg - 4, dir, nullptr, nullptr, nullptr, nullptr, 4, smem);
      }
      xcd_barrier(xb);
      for (int it = bid; it < 768; it += nb) {
        const int seg = 95 - (it >> 3), hg = it & 7;
        if (hg < 4) scan_work<1, 128>(p, false, seg, hg, hg, 0, p.in[I_GLAF], p.in[I_GLAB], p.out + OUT_GLAF, p.out + OUT_GLAB, 4, smem);
        else scan_work<2, 128>(p, false, seg, hg, hg - 4, 0, p.in[I_HGF], p.in[I_HGB], p.out + OUT_HGF, p.out + OUT_HGB, 4, smem);
      }
      {
        const int idle0 = (768 - nb) > 0 ? (768 - nb) : 0;
        const int n_up = convert_ntiles(1024, 5632), n_dn = convert_ntiles(2816, 1024);
        if (bid >= idle0)
          for (int it = bid - idle0; it < n_up + n_dn; it += nb - idle0) {
            if (it < n_up) convert_tile(p.in[I_WUP] + (unsigned)1024 * 5632, Wt_up, 1024, 5632, it, smem);
            else convert_tile(p.in[I_WDN] + (unsigned)2816 * 1024, Wt_dn, 2816, 1024, it - n_up, smem);
          }
      }
      xcd_barrier(xb);
    }
    {
      for (int r = 0;; r++) {
        int mt, nt;
        if (!tile_swizzle(r, 96, 8, mt, nt)) break;
        ARowPlain af{1024};
        BRowClamp bf{1024, nt * 128, 1024};
        EpiResid ep{p.in[I_XP], p.in[I_XS], layer == 0, p.out, mods_l + 2048, mt * 256, nt * 128};
        gemm_tile(hb + (unsigned)mt * 256 * 1024, Wt_out, zrow, af, bf, 1024, ep, smem);
      }
    }
    xcd_barrier(xb);
    normmod_phase(p, layer, 1, false);
    if (layer == 0) {
      const int n_out = convert_ntiles(1024, 1024);
      for (int it = bid; it < n_out; it += nb) convert_tile(p.in[I_WOUT1], Wt_out, 1024, 1024, it, smem);
    }
    xcd_barrier(xb);
    {
      bf16_t* act = ub;
      const float* cw = p.in[I_FCW] + (unsigned)layer * 3 * 5632;
      const float* cb = p.in[I_FCB] + (unsigned)layer * 5632;
      for (int r = 0;; r++) {
        int mt, nt;
        if (!tile_swizzle(r, 104, 44, mt, nt)) break;
        if (mt >= 100) continue;
        int lo, hi, t0;
        bool halo;
        if (mt < 32) { lo = mt * 256; hi = lo + 256; t0 = lo; halo = false; }
        else { const int m2 = mt - 32; const int sq = m2 / 17; const int j = m2 - sq * 17; lo = NPTOK + sq * 4096; hi = lo + 4096; t0 = lo + 254 * j - 1; halo = true; }
        ARowHalo af{t0, lo, hi};
        BRowUp bf{nt * 64};
        EpiConv ep{act, cw, cb, t0, hi, nt * 64, halo};
        gemm_tile(hb, Wt_up, zrow, af, bf, 1024, ep, smem);
      }
    }
    xcd_barrier(xb);
    {
      const bf16_t* act = ub;
      for (int r = 0;; r++) {
        int mt, nt;
        if (!tile_swizzle(r, 96, 8, mt, nt)) break;
        ARowPlain af{FFN};
        BRowClamp bf{FFN, nt * 128, 1024};
        EpiResid ep{p.in[I_XP], p.in[I_XS], false, p.out, mods_l + 5120, mt * 256, nt * 128};
        gemm_tile(act + (unsigned)mt * 256 * FFN, Wt_dn, zrow, af, bf, FFN, ep, smem);
      }
    }
    if (layer == 0) xcd_barrier(xb);
}

__global__ void __launch_bounds__(256, 2) __attribute__((amdgpu_waves_per_eu(2, 2))) mega(Params p) {
  __shared__ __align__(16) unsigned char smem[SMEM_BYTES];
  __shared__ uint4 xb_words;
  if (p.out == nullptr) { cg::grid_group grid = cg::this_grid(); grid.sync(); }
  if (threadIdx.x == 0) xb_words = make_uint4(0u, 0u, 0u, 0u);
  __syncthreads();
  const XcdBarrier xb = xcd_barrier_post((unsigned*)(p.ws + OFF_BAR), (volatile LAS unsigned*)&xb_words);
  const int bid = blockIdx.x, nb = gridDim.x;
  bf16_t* Wt_in = (bf16_t*)(p.ws + OFF_WIN);
  bf16_t* Wt_out = (bf16_t*)(p.ws + OFF_WOUT);
  bf16_t* Wt_up = (bf16_t*)(p.ws + OFF_WUP);
  bf16_t* Wt_dn = (bf16_t*)(p.ws + OFF_WDN);
  bf16_t* ub = (bf16_t*)(p.ws + OFF_U);
  bf16_t* hb = (bf16_t*)(p.ws + OFF_H);
  const float* mods = (const float*)(p.ws + OFF_MODS);

  {
    const int n_in = convert_ntiles(1024, 2832), n_out = convert_ntiles(1024, 1024);
    const int total = 384 + n_in + n_out;
    for (int it = bid; it < total; it += nb) {
      int t = it;
      if (t < 384) { mods_item(p, t, smem); continue; }
      t -= 384;
      if (t < n_in) { convert_tile(p.in[I_WIN0], Wt_in, 1024, 2832, t, smem); continue; }
      t -= n_in;
      convert_tile(p.in[I_WOUT0], Wt_out, 1024, 1024, t, smem);
    }
  }
  {
    const int g = blockIdx.x * 256 + (opaque_tid() & 255);
    for (int i = g; i < 131072; i += gridDim.x * 256) {
      const int which = i >> 16, e = (i & 65535) * 8;
      const float* src = (which ? p.in[I_CV] : p.in[I_CK]) + e;
      const float4 a = *(const float4*)src, c = *(const float4*)(src + 4);
      uint4 o; o.x = pack2(a.x, a.y); o.y = pack2(a.z, a.w); o.z = pack2(c.x, c.y); o.w = pack2(c.z, c.w);
      *(uint4*)((bf16_t*)(p.ws + (which ? OFF_CVB : OFF_CKB)) + e) = o;
    }
  }
  xcd_barrier(xb);

  layer_body<0>(p, smem, xb);
  layer_body<1>(p, smem, xb);
}

extern "C" void kernel_launch(void* const* d_in, const int* in_sizes, int n_in,
                              void* d_out, int out_size, void* d_ws, size_t ws_size,
                              hipStream_t stream) {
  static int grid_blocks = 0;
  if (!grid_blocks) {
    int dev = 0, cus = 0, per_cu = 0;
    (void)hipGetDevice(&dev);
    (void)hipDeviceGetAttribute(&cus, hipDeviceAttributeMultiprocessorCount, dev);
    (void)hipOccupancyMaxActiveBlocksPerMultiprocessor(&per_cu, mega, 256, 0);
    if (per_cu > 2) per_cu = 2;
    if (per_cu < 1) per_cu = 1;
    grid_blocks = cus * per_cu;
  }
  Params p{};
  for (int i = 0; i < 37; i++) p.in[i] = (const float*)d_in[i];
  p.out = (float*)d_out;
  p.ws = (unsigned char*)d_ws;
  void* args[] = {&p};
  (void)hipMemsetAsync((unsigned char*)d_ws + OFF_BAR, 0, XCD_BAR_WORDS * 4, stream);
  hipError_t e = hipLaunchCooperativeKernel((void*)mega, dim3(grid_blocks), dim3(256), args, 0, stream);
  if (e != hipSuccess) fprintf(stderr, "cooperative launch failed: %s (grid %d)\n", hipGetErrorString(e), grid_blocks);
}
```

```cpp
#include <hip/hip_runtime.h>
#include <hip/hip_cooperative_groups.h>
#include <cstdio>
namespace cg = cooperative_groups;

typedef unsigned short bf16_t;
typedef __attribute__((ext_vector_type(8))) short s8v;
typedef __attribute__((ext_vector_type(4))) float f4v;
typedef __attribute__((ext_vector_type(16))) float f16v;
typedef __attribute__((ext_vector_type(4))) unsigned u4v;

__device__ __forceinline__ int opaque_tid() { int t = threadIdx.x; asm volatile("" : "+v"(t)); return t; }

#define NTOK 24576
#define NPTOK 8192
#define DM 1024
#define UST 3360
#define FFN 2816
#define EPSV 1e-6f

#define OFF_WIN 0ull
#define OFF_WOUT 6881280ull
#define OFF_WUP 8978432ull
#define OFF_WDN 20512768ull
#define OFF_U 26279936ull
#define OFF_H 191430656ull
#define OFF_SL 241762304ull
#define OFF_DL 258539520ull
#define OFF_MODS 258801664ull
#define OFF_LB 259047424ull
#define OFF_BAR 259049472ull
#define OFF_ZROW 259063296ull
#define OFF_CKB 259071488ull
#define OFF_CVB 260120064ull

#define OUT_NAK 25165824ull
#define OUT_NAV 29360128ull
#define OUT_SSDF 33554432ull
#define OUT_SSDB 34603008ull
#define OUT_GLAF 35651584ull
#define OUT_GLAB 36700160ull
#define OUT_HGF 37748736ull
#define OUT_HGB 38797312ull

#define SMEM_BYTES 73728

struct Params {
  const float* in[37];
  float* out;
  unsigned char* ws;
};

enum {
  I_XP = 0, I_XS, I_CK, I_CV, I_SSDF, I_SSDB, I_GLAF, I_GLAB, I_HGF, I_HGB, I_C, I_CCTX, I_WADA, I_BADA, I_NORMW,
  I_WUP, I_FCW, I_FCB, I_WDN, I_WIN0, I_WOUT0, I_SCW, I_SCB, I_DTB, I_ALOG, I_SSDD, I_SSDNW, I_QN, I_KN, I_RPB,
  I_WIN1, I_WOUT1, I_WA2, I_BA2, I_GLANW, I_LBL, I_HGNW
};

typedef __bf16 bf2v __attribute__((ext_vector_type(2)));
typedef float f2v __attribute__((ext_vector_type(2)));
__device__ __forceinline__ unsigned pack2(float a, float b) {
  f2v v = {a, b};
  bf2v r = __builtin_convertvector(v, bf2v);
  return __builtin_bit_cast(unsigned, r);
}
__device__ __forceinline__ bf16_t f2bf(float f) { return (bf16_t)(pack2(f, f) & 0xffffu); }
__device__ __forceinline__ float bf2f(bf16_t h) { return __uint_as_float(((unsigned)h) << 16); }
__device__ __forceinline__ float bflo(unsigned w) { return __uint_as_float(w << 16); }
__device__ __forceinline__ float bfhi(unsigned w) { return __uint_as_float(w & 0xffff0000u); }
__device__ __forceinline__ float siluf(float x) { return x * __builtin_amdgcn_rcpf(1.f + __expf(-x)); }
__device__ __forceinline__ float sigmf(float x) { return __builtin_amdgcn_rcpf(1.f + __expf(-x)); }
__device__ __forceinline__ void unpack8(uint4 v, float* f) {
  f[0] = bflo(v.x); f[1] = bfhi(v.x); f[2] = bflo(v.y); f[3] = bfhi(v.y);
  f[4] = bflo(v.z); f[5] = bfhi(v.z); f[6] = bflo(v.w); f[7] = bfhi(v.w);
}
__device__ __forceinline__ void halves8(uint4 v, bf16_t* h) {
  h[0] = (bf16_t)(v.x & 0xffffu); h[1] = (bf16_t)(v.x >> 16); h[2] = (bf16_t)(v.y & 0xffffu); h[3] = (bf16_t)(v.y >> 16);
  h[4] = (bf16_t)(v.z & 0xffffu); h[5] = (bf16_t)(v.z >> 16); h[6] = (bf16_t)(v.w & 0xffffu); h[7] = (bf16_t)(v.w >> 16);
}
__device__ __forceinline__ uint4 pack8(const float* f) {
  uint4 v; v.x = pack2(f[0], f[1]); v.y = pack2(f[2], f[3]); v.z = pack2(f[4], f[5]); v.w = pack2(f[6], f[7]); return v;
}
__device__ __forceinline__ int condof(int row) { return row < NPTOK ? 0 : 1 + ((row - NPTOK) >> 12); }

template <int CTRL>
__device__ __forceinline__ float dppx(float v) { return __int_as_float(__builtin_amdgcn_update_dpp(0, __float_as_int(v), CTRL, 0xF, 0xF, true)); }
__device__ __forceinline__ float quad_sum(float v) { v += dppx<0xB1>(v); v += dppx<0x4E>(v); return v; }
__device__ __forceinline__ float red16_sum(float v) { v += dppx<0xB1>(v); v += dppx<0x4E>(v); v += dppx<0x141>(v); v += dppx<0x140>(v); return v; }
__device__ __forceinline__ float red16_max(float v) {
  v = fmaxf(v, dppx<0xB1>(v)); v = fmaxf(v, dppx<0x4E>(v)); v = fmaxf(v, dppx<0x141>(v)); v = fmaxf(v, dppx<0x140>(v)); return v;
}

#define MFMA16(a, b, c) __builtin_amdgcn_mfma_f32_16x16x32_bf16(a, b, c, 0, 0, 0)
#define MFMA32(a, b, c) __builtin_amdgcn_mfma_f32_32x32x16_bf16(a, b, c, 0, 0, 0)

#define XB_TMO      128
#define XB_XCNT(j)  (256  + 64 * (j))
#define XB_XSUB(j)  (1280 + 64 * (j))
#define XB_XGEN(j)  (2304 + 64 * (j))
#define XB_TOP      3328
#define XB_TOPGEN   3392
#define XCD_BAR_WORDS 3456
#define XB_SPIN_CAP (1u << 22)
#define LAS __attribute__((address_space(3)))
__device__ __forceinline__ unsigned xb_ld(unsigned* p) { return __hip_atomic_load(p, __ATOMIC_RELAXED, __HIP_MEMORY_SCOPE_AGENT); }
__device__ __forceinline__ unsigned xb_add(unsigned* p, unsigned v) { return __hip_atomic_fetch_add(p, v, __ATOMIC_RELAXED, __HIP_MEMORY_SCOPE_AGENT); }
__device__ __forceinline__ unsigned xb_xcc_id() { return (unsigned)__builtin_amdgcn_s_getreg((3 << 11) | 20) & 0xFu; }
#define XB_SPIN(cond, bar) do { unsigned _sp = 0; while (cond) { __builtin_amdgcn_s_sleep(1); \
    if ((++_sp & 255u) == 0u) { if (xb_ld(&(bar)[XB_TMO])) break; if (_sp > XB_SPIN_CAP) { atomicAdd(&(bar)[XB_TMO], 1u); break; } } } } while (0)
struct XcdBarrier { unsigned* bar; unsigned x; volatile LAS unsigned* st; };
__device__ __forceinline__ XcdBarrier xcd_barrier_post(unsigned* bar, volatile LAS unsigned* st) {
  XcdBarrier b; b.bar = bar; b.x = xb_xcc_id(); b.st = st;
  if (threadIdx.x == 0) (void)xb_add(&bar[XB_XCNT(b.x)], 1u);
  return b;
}
__device__ __forceinline__ void xcd_barrier_complete(unsigned* bar, unsigned x, unsigned& nloc, unsigned& nx) {
  const unsigned G = gridDim.x * gridDim.y * gridDim.z;
  unsigned sum, cnt, mine, sp = 0u;
  for (;;) {
    sum = 0u; cnt = 0u; mine = 0u;
#pragma unroll
    for (unsigned j = 0; j < 16; ++j) { const unsigned c = xb_ld(&bar[XB_XCNT(j)]); sum += c; cnt += (c > 0u) ? 1u : 0u; mine = (j == x) ? c : mine; }
    if (sum == G) break;
    __builtin_amdgcn_s_sleep(1);
    if ((++sp & 255u) == 0u) { if (xb_ld(&bar[XB_TMO])) break; if (sp > XB_SPIN_CAP) { atomicAdd(&bar[XB_TMO], 1u); break; } }
  }
  nloc = mine > 0u ? mine : 1u; nx = cnt > 0u ? cnt : 1u;
}
__device__ __forceinline__ void xcd_barrier(const XcdBarrier& b) {
  asm volatile("s_waitcnt vmcnt(0)" ::: "memory");
  __syncthreads();
  if (threadIdx.x == 0) {
    unsigned* bar = b.bar;
    __builtin_amdgcn_s_waitcnt(0);
    unsigned nloc = b.st[0], nx = b.st[1];
    if (nloc == 0u) { xcd_barrier_complete(bar, b.x, nloc, nx); b.st[0] = nloc; b.st[1] = nx; }
    const unsigned old = xb_add(&bar[XB_XSUB(b.x)], 1u);
    const unsigned gen = old / nloc;
    if (old + 1u == (gen + 1u) * nloc) {
      __builtin_amdgcn_fence(__ATOMIC_RELEASE, "agent");
      asm volatile("s_waitcnt vmcnt(0)" ::: "memory");
      const unsigned og = xb_add(&bar[XB_TOP], 1u);
      const unsigned tg = og / nx;
      if (og + 1u == (tg + 1u) * nx) xb_add(&bar[XB_TOPGEN], 1u);
      else XB_SPIN(xb_ld(&bar[XB_TOPGEN]) == tg, bar);
      __builtin_amdgcn_fence(__ATOMIC_ACQUIRE, "agent");
      xb_add(&bar[XB_XGEN(b.x)], 1u);
      asm volatile("s_waitcnt vmcnt(0)" ::: "memory");
    } else {
      XB_SPIN(xb_ld(&bar[XB_XGEN(b.x)]) == gen, bar);
      __builtin_amdgcn_fence(__ATOMIC_ACQUIRE, "agent");
      asm volatile("s_waitcnt vmcnt(0)" ::: "memory");
    }
  }
  __syncthreads();
}

__device__ __forceinline__ void convert_tile(const float* __restrict__ W, bf16_t* __restrict__ Wt, int K, int N, int tile, unsigned char* smem) {
  float* lds = (float*)smem;
  const int ntn = (N + 63) >> 6;
  const int kt = tile / ntn, nt = tile - kt * ntn;
  const int k0 = kt * 64, n0 = nt * 64;
  const int tid = opaque_tid();
  __syncthreads();
  {
    const int n = n0 + (tid & 63);
    const int nc = n < N ? n : N - 1;
    float v[16];
#pragma unroll
    for (int i = 0; i < 16; i++) v[i] = W[(unsigned)(k0 + (tid >> 6) + 4 * i) * N + nc];
#pragma unroll
    for (int i = 0; i < 16; i++) lds[(tid & 63) * 65 + (tid >> 6) + 4 * i] = v[i];
  }
  __syncthreads();
  const int nl = tid >> 2, kq = tid & 3;
  if (n0 + nl < N) {
    float f[16];
#pragma unroll
    for (int j = 0; j < 16; j++) f[j] = lds[nl * 65 + kq * 16 + j];
    uint4* dst = (uint4*)(Wt + (unsigned)(n0 + nl) * K + k0 + kq * 16);
    dst[0] = pack8(f);
    dst[1] = pack8(f + 8);
  }
}
__device__ __forceinline__ int convert_ntiles(int K, int N) { return (K >> 6) * ((N + 63) >> 6); }

__device__ __forceinline__ void mods_item(const Params& p, int item, unsigned char* smem) {
  float* sc = (float*)smem;
  float* red = sc + 5 * 1024;
  const int tid = opaque_tid();
  __syncthreads();
  {
    float cvv[20];
#pragma unroll
    for (int q = 0; q < 20; q++) {
      const int i = tid + 256 * q, cv = i >> 10, k = i & 1023;
      const float* src = (cv == 0) ? (p.in[I_CCTX] + k) : (p.in[I_C] + (cv - 1) * 1024 + k);
      cvv[q] = *src;
    }
#pragma unroll
    for (int q = 0; q < 20; q++) sc[tid + 256 * q] = siluf(cvv[q]);
  }
  __syncthreads();
  const int l = item / 384, n0 = (item % 384) * 16;
  const int nl = tid & 15, kp = tid >> 4;
  const float* W = p.in[I_WADA] + (unsigned)l * 1024 * 6144 + n0 + nl;
  float acc[5] = {0.f, 0.f, 0.f, 0.f, 0.f};
  for (int k0 = kp * 64; k0 < kp * 64 + 64; k0 += 32) {
    float wv[32];
#pragma unroll
    for (int j = 0; j < 32; j++) wv[j] = W[(unsigned)(k0 + j) * 6144];
#pragma unroll
    for (int j = 0; j < 32; j++)
#pragma unroll
      for (int cv = 0; cv < 5; cv++) acc[cv] += sc[cv * 1024 + k0 + j] * wv[j];
  }
#pragma unroll
  for (int cv = 0; cv < 5; cv++) red[(kp * 5 + cv) * 16 + nl] = acc[cv];
  __syncthreads();
  float* mods = (float*)(p.ws + OFF_MODS);
  if (tid < 5 * 16) {
    const int cv = tid >> 4, n = tid & 15;
    float s = 0.f;
#pragma unroll
    for (int q = 0; q < 16; q++) s += red[(q * 5 + cv) * 16 + n];
    mods[((unsigned)l * 5 + cv) * 6144 + n0 + n] = s + p.in[I_BADA][l * 6144 + n0 + n];
  }
  if (item == 0) {
    for (int i = tid; i < 2048; i += 256) ((unsigned*)(p.ws + OFF_ZROW))[i] = 0u;
    float* lb = (float*)(p.ws + OFF_LB);
    for (int i = tid; i < 512; i += 256) {
      int d = i >> 8, j = i & 255;
      float l0 = p.in[I_LBL][d * 512 + j], l1 = p.in[I_LBL][d * 512 + 256 + j];
      lb[i] = 1.f / (1.f + __expf(l0 - l1));
    }
  }
}

__device__ __forceinline__ void normmod_phase(const Params& p, int layer, int which  , bool from_input) {
  const float* mods = (const float*)(p.ws + OFF_MODS) + (unsigned)layer * 5 * 6144;
  const float* nw = p.in[I_NORMW] + (layer * 2 + which) * 1024;
  const int sh_off = which ? 3072 : 0, sc_off = which ? 4096 : 1024;
  bf16_t* hb = (bf16_t*)(p.ws + OFF_H);
  const int lane = opaque_tid() & 63, wave = opaque_tid() >> 6;
  for (int item = blockIdx.x; item < NTOK / 8; item += gridDim.x) {
    const int row = item * 8 + wave * 2;
    const float* x = from_input ? (row < NPTOK ? p.in[I_XP] + (unsigned)row * 1024 : p.in[I_XS] + (unsigned)(row - NPTOK) * 1024)
                                : p.out + (unsigned)row * 1024;
    const float* md = mods + condof(row) * 6144;
    float4 v[2][4];
    float ss0 = 0.f, ss1 = 0.f;
#pragma unroll
    for (int j = 0; j < 4; j++) {
      v[0][j] = ((const float4*)x)[lane + 64 * j];
      v[1][j] = ((const float4*)(x + 1024))[lane + 64 * j];
    }
    float4 wv[4], sv[4], hv[4];
#pragma unroll
    for (int j = 0; j < 4; j++) {
      const int col = 4 * (lane + 64 * j);
      wv[j] = *(const float4*)(nw + col);
      sv[j] = *(const float4*)(md + sc_off + col);
      hv[j] = *(const float4*)(md + sh_off + col);
    }
#pragma unroll
    for (int j = 0; j < 4; j++) {
      ss0 += v[0][j].x * v[0][j].x + v[0][j].y * v[0][j].y + v[0][j].z * v[0][j].z + v[0][j].w * v[0][j].w;
      ss1 += v[1][j].x * v[1][j].x + v[1][j].y * v[1][j].y + v[1][j].z * v[1][j].z + v[1][j].w * v[1][j].w;
    }
#pragma unroll
    for (int m = 32; m >= 1; m >>= 1) { ss0 += __shfl_xor(ss0, m); ss1 += __shfl_xor(ss1, m); }
    const float r0 = rsqrtf(ss0 * (1.f / 1024.f) + EPSV), r1 = rsqrtf(ss1 * (1.f / 1024.f) + EPSV);
#pragma unroll
    for (int j = 0; j < 4; j++) {
      const int col = 4 * (lane + 64 * j);
      const float4 w = wv[j], s = sv[j], h = hv[j];
      const float m0 = w.x * (1.f + s.x), m1 = w.y * (1.f + s.y), m2 = w.z * (1.f + s.z), m3 = w.w * (1.f + s.w);
      uint2 pk;
      pk.x = pack2(v[0][j].x * r0 * m0 + h.x, v[0][j].y * r0 * m1 + h.y);
      pk.y = pack2(v[0][j].z * r0 * m2 + h.z, v[0][j].w * r0 * m3 + h.w);
      *(uint2*)(hb + (unsigned)row * 1024 + col) = pk;
      pk.x = pack2(v[1][j].x * r1 * m0 + h.x, v[1][j].y * r1 * m1 + h.y);
      pk.y = pack2(v[1][j].z * r1 * m2 + h.z, v[1][j].w * r1 * m3 + h.w);
      *(uint2*)(hb + (unsigned)(row + 1) * 1024 + col) = pk;
    }
  }
}

#define G_STAGE_BYTES 24576
__device__ __forceinline__ void lds_dma16(unsigned voff, const void* sbase, unsigned lds_uniform) {
  asm volatile("s_mov_b32 m0, %2\n\ts_nop 0\n\tglobal_load_lds_dwordx4 %0, %1" ::"v"(voff), "s"(sbase), "s"(lds_uniform) : "memory");
}
template <class AF, class BF, class EF>
__device__ __forceinline__ void gemm_tile(const bf16_t* __restrict__ Abase, const bf16_t* __restrict__ Bbase, const bf16_t* __restrict__ zrow,
                                          AF arow, BF brow, int K, EF& epi, unsigned char* smem) {
  const int tid = opaque_tid() & 255, lane = tid & 63, wave = tid >> 6;
  const int wm = wave >> 1, wn = wave & 1;
  unsigned ao[4], bo[2];
  const int cch = ((lane & 3) ^ ((lane >> 4) & 3)) * 8;
  const int zoff = (int)(zrow - Abase);
#pragma unroll
  for (int i = 0; i < 4; i++) {
    const int row = (wave + 4 * i) * 16 + (lane >> 2);
    const int a = arow(row);
    ao[i] = (unsigned)(((a >= 0) ? a : zoff) + cch) * 2u;
  }
#pragma unroll
  for (int i = 0; i < 2; i++) {
    const int row = (wave + 4 * i) * 16 + (lane >> 2);
    bo[i] = (unsigned)(brow(row) + cch) * 2u;
  }
  f16v acc[4][2];
#pragma unroll
  for (int i = 0; i < 4; i++)
#pragma unroll
    for (int j = 0; j < 2; j++)
#pragma unroll
      for (int r = 0; r < 16; r++) acc[i][j][r] = 0.f;

  const unsigned lds0 = (unsigned)(size_t)((LAS unsigned char*)smem) + wave * 1024;
  auto stage = [&](int buf, int k0) __attribute__((always_inline)) {
    const unsigned la = __builtin_amdgcn_readfirstlane(lds0 + buf * G_STAGE_BYTES);
    const bf16_t* ab = Abase + k0;
    const bf16_t* bb = Bbase + k0;
#pragma unroll
    for (int i = 0; i < 4; i++) lds_dma16(ao[i], ab, la + i * 4096);
#pragma unroll
    for (int i = 0; i < 2; i++) lds_dma16(bo[i], bb, la + 16384 + i * 4096);
  };
  int xo[2];
#pragma unroll
  for (int kk = 0; kk < 2; kk++) xo[kk] = (((kk * 2 + (lane >> 5)) ^ ((lane >> 2) & 3)) * 16);
  const int arow_b = (wm * 128 + (lane & 31)) * 64;
  const int brow_b = 16384 + (wn * 64 + (lane & 31)) * 64;
  auto compute = [&](int buf) __attribute__((always_inline)) {
    const unsigned char* S = smem + buf * G_STAGE_BYTES;
    s8v a[2][4], b[2][2];
#pragma unroll
    for (int kk = 0; kk < 2; kk++) {
#pragma unroll
      for (int i = 0; i < 4; i++) a[kk][i] = *(const s8v*)(S + arow_b + i * 2048 + xo[kk]);
#pragma unroll
      for (int j = 0; j < 2; j++) b[kk][j] = *(const s8v*)(S + brow_b + j * 2048 + xo[kk]);
    }
#pragma unroll
    for (int kk = 0; kk < 2; kk++)
#pragma unroll
      for (int i = 0; i < 4; i++)
#pragma unroll
        for (int j = 0; j < 2; j++) acc[i][j] = MFMA32(a[kk][i], b[kk][j], acc[i][j]);
  };
  const int nk = K >> 5;
  stage(0, 0);
  stage(1, 32);
  asm volatile("s_waitcnt vmcnt(6)" ::: "memory");
  __syncthreads();
  int cur = 0;
#pragma unroll 1
  for (int kt = 0; kt < nk; kt++) {
    const bool more = (kt + 2 < nk);
    int nx = cur + 2; nx = nx >= 3 ? nx - 3 : nx;
    if (more) stage(nx, (kt + 2) << 5);
    compute(cur);
    if (more) asm volatile("s_waitcnt vmcnt(6)" ::: "memory");
    else asm volatile("s_waitcnt vmcnt(0)" ::: "memory");
    __syncthreads();
    cur = cur == 2 ? 0 : cur + 1;
  }
  epi(acc, wm, wn, lane, smem);
}

#define CROW(wm, i, reg, lane) ((wm) * 128 + (i) * 32 + ((reg) & 3) + 8 * ((reg) >> 2) + 4 * ((lane) >> 5))
#define CCOL(wn, j, lane) ((wn) * 64 + (j) * 32 + ((lane) & 31))

__device__ __forceinline__ bool tile_swizzle(int r, int MT8  , int NT, int& m, int& n) {
  const int bid = blockIdx.x, G = gridDim.x;
  const int per = G >> 3;
  const int total = MT8 * NT;
  const int full = total / G;
  int q;
  if (r < full && (G & 7) == 0) q = (r * 8 + (bid & 7)) * per + (bid >> 3);
  else if (r <= full) q = r * G + bid;
  else return false;
  q = __builtin_amdgcn_readfirstlane(q);
  if (q >= total) return false;
  const int sr = q / (8 * NT);
  const int rem = q - sr * 8 * NT;
  n = rem >> 3;
  m = sr * 8 + (rem & 7);
  return true;
}

struct ARowPlain {
  int ld;
  __device__ __forceinline__ int operator()(int i) const { return i * ld; }
};
struct BRowClamp {
  int ld; int n0; int N;
  __device__ __forceinline__ int operator()(int j) const { int n = n0 + j; n = n < N ? n : N - 1; return n * ld; }
};
struct EpiStoreU {
  bf16_t* u; int m0; int n0; int N;
  __device__ __forceinline__ void operator()(f16v (&acc)[4][2], int wm, int wn, int lane, unsigned char*) {
#pragma unroll
    for (int i = 0; i < 4; i++)
#pragma unroll
      for (int j = 0; j < 2; j++) {
        const int col = n0 + CCOL(wn, j, lane);
        if (col < N) {
#pragma unroll
          for (int r = 0; r < 16; r += 2) {
            const int row = m0 + CROW(wm, i, r, lane);
            const unsigned pk = pack2(acc[i][j][r], acc[i][j][r + 1]);
            u[(unsigned)row * UST + col] = (bf16_t)(pk & 0xffffu);
            u[(unsigned)(row + 1) * UST + col] = (bf16_t)(pk >> 16);
          }
        }
      }
  }
};
struct EpiResid {
  const float* xp; const float* xs; bool from_input; float* out; const float* gate;   int m0; int n0;
  __device__ __forceinline__ void operator()(f16v (&acc)[4][2], int wm, int wn, int lane, unsigned char*) {
    const float* g = gate + condof(m0) * 6144;
    const float* rsrc = from_input ? ((m0 < NPTOK) ? xp : (xs - (size_t)NPTOK * 1024)) : (const float*)out;
    const int col0 = n0 + CCOL(wn, 0, lane), col1 = n0 + CCOL(wn, 1, lane);
    const float gv0 = g[col0], gv1 = g[col1];
#pragma unroll
    for (int i = 0; i < 4; i++) {
      float res0[16], res1[16];
#pragma unroll
      for (int r = 0; r < 16; r++) {
        const unsigned ro = (unsigned)(m0 + CROW(wm, i, r, lane)) * 1024;
        res0[r] = rsrc[ro + col0];
        res1[r] = rsrc[ro + col1];
      }
#pragma unroll
      for (int r = 0; r < 16; r++) {
        const unsigned ro = (unsigned)(m0 + CROW(wm, i, r, lane)) * 1024;
        out[ro + col0] = res0[r] + gv0 * acc[i][0][r];
        out[ro + col1] = res1[r] + gv1 * acc[i][1][r];
      }
    }
  }
};
struct ARowHalo {
  int t0; int lo; int hi;
  __device__ __forceinline__ int operator()(int i) const { int t = t0 + i; return (t >= lo && t < hi) ? t * 1024 : -1; }
};
struct BRowUp {
  int n0;
  __device__ __forceinline__ int operator()(int j) const { int n = (j < 64) ? (n0 + j) : (FFN + n0 + j - 64); return n * 1024; }
};
struct EpiConv {
  bf16_t* act; const float* cw; const float* cb; int t0; int hi; int n0; bool halo;
  __device__ __forceinline__ void operator()(f16v (&acc)[4][2], int wm, int wn, int lane, unsigned char* smem) {
    bf16_t* sC = (bf16_t*)smem;
#pragma unroll
    for (int i = 0; i < 4; i++)
#pragma unroll
      for (int j = 0; j < 2; j++)
#pragma unroll
        for (int r = 0; r < 16; r += 2) {
          const unsigned pk = pack2(acc[i][j][r], acc[i][j][r + 1]);
          sC[CROW(wm, i, r, lane) * 136 + CCOL(wn, j, lane)] = (bf16_t)(pk & 0xffffu);
          sC[(CROW(wm, i, r, lane) + 1) * 136 + CCOL(wn, j, lane)] = (bf16_t)(pk >> 16);
        }
    __syncthreads();
    const int tid = opaque_tid() & 255;
    const int cp = tid & 31, rg = tid >> 5;
    const int ca = n0 + 2 * cp, cbi = FFN + n0 + 2 * cp;
    const float2 wa0 = *(const float2*)(cw + ca), wa1 = *(const float2*)(cw + 2 * FFN + ca), wa2 = *(const float2*)(cw + 4 * FFN + ca), ba = *(const float2*)(cb + ca);
    const float2 wb0 = *(const float2*)(cw + cbi), wb1 = *(const float2*)(cw + 2 * FFN + cbi), wb2 = *(const float2*)(cw + 4 * FFN + cbi), bb = *(const float2*)(cb + cbi);
    const int first = halo ? 1 : 0, last = halo ? 254 : 255;
    int ilo = 32 * rg, ihi = 32 * rg + 31;
    ilo = ilo < first ? first : ilo;
    ihi = ihi > last ? last : ihi;
    const bf16_t* sa = sC + 2 * cp;
    const bf16_t* sb = sC + 64 + 2 * cp;
    unsigned ap = ilo > 0 ? *(const unsigned*)(sa + (ilo - 1) * 136) : 0u, ac = *(const unsigned*)(sa + ilo * 136);
    unsigned bp = ilo > 0 ? *(const unsigned*)(sb + (ilo - 1) * 136) : 0u, bc = *(const unsigned*)(sb + ilo * 136);
    for (int i = ilo; i <= ihi; i++) {
      const unsigned an = i < 255 ? *(const unsigned*)(sa + (i + 1) * 136) : 0u;
      const unsigned bn = i < 255 ? *(const unsigned*)(sb + (i + 1) * 136) : 0u;
      const int tok = t0 + i;
      if (tok < hi) {
        const float a0 = ba.x + wa0.x * bflo(ap) + wa1.x * bflo(ac) + wa2.x * bflo(an);
        const float a1 = ba.y + wa0.y * bfhi(ap) + wa1.y * bfhi(ac) + wa2.y * bfhi(an);
        const float b0 = bb.x + wb0.x * bflo(bp) + wb1.x * bflo(bc) + wb2.x * bflo(bn);
        const float b1 = bb.y + wb0.y * bfhi(bp) + wb1.y * bfhi(bc) + wb2.y * bfhi(bn);
        *(unsigned*)(act + (unsigned)tok * FFN + n0 + 2 * cp) = pack2(siluf(a0) * b0, siluf(a1) * b1);
      }
      ap = ac; ac = an; bp = bc; bc = bn;
    }
    __syncthreads();
  }
};

__device__ __forceinline__ void attn_item(const Params& p, int item, unsigned char* smem) {
  bf16_t* sQ = (bf16_t*)smem;
  bf16_t* sK = sQ + 64 * 72;
  bf16_t* sVt = sK + 64 * 72;
  bf16_t* sP = sVt + 64 * 72;
  const bf16_t* u = (const bf16_t*)(p.ws + OFF_U);
  bf16_t* hb = (bf16_t*)(p.ws + OFF_H);
  const int tid = opaque_tid(), lane = tid & 63, w = tid >> 6;
  const bool latent = item >= 1024;
  int tq0, h, nkt, seq = 0, qt = 0, b = 0, r = 0, rs = 0;
  if (!latent) {
    seq = item >> 5; h = (item >> 2) & 7; qt = item & 3;
    tq0 = seq * 256 + qt * 64; nkt = 4;
  } else {
    const int it = item - 1024;
    b = it >> 9; h = (it >> 6) & 7; r = it & 63;
    tq0 = NPTOK + b * 4096 + r * 64; nkt = 12;
    rs = r - 4; rs = rs < 0 ? 0 : (rs > 56 ? 56 : rs);
  }
  const int lrow = tid >> 2, lq = tid & 3;
  __syncthreads();
  {
    const bf16_t* src = u + (unsigned)(tq0 + lrow) * UST + 1296 + h * 64 + lq * 16;
    float f[16];
    unpack8(*(const uint4*)src, f);
    unpack8(*(const uint4*)(src + 8), f + 8);
    float ss = 0.f;
#pragma unroll
    for (int j = 0; j < 16; j++) ss += f[j] * f[j];
    ss = quad_sum(ss);
    const float sc = rsqrtf(ss * (1.f / 64.f) + EPSV) * 0.125f;
    const float* qn = p.in[I_QN] + lq * 16;
#pragma unroll
    for (int j = 0; j < 16; j++) f[j] = f[j] * sc * qn[j];
    *(uint4*)(sQ + lrow * 72 + lq * 16) = pack8(f);
    *(uint4*)(sQ + lrow * 72 + lq * 16 + 8) = pack8(f + 8);
  }
  f4v o[4];
#pragma unroll
  for (int d = 0; d < 4; d++) o[d] = (f4v){0.f, 0.f, 0.f, 0.f};
  float m_run[4] = {-1e30f, -1e30f, -1e30f, -1e30f};
  float l_run[4] = {0.f, 0.f, 0.f, 0.f};
  float* sRPB = (float*)(smem + 4 * 64 * 72 * 2);
  if (latent) {
    const float r0 = p.in[I_RPB][h * 15 * 31 + tid];
    const float r1 = (tid + 256 < 15 * 31) ? p.in[I_RPB][h * 15 * 31 + tid + 256] : 0.f;
    sRPB[tid] = r0;
    if (tid + 256 < 15 * 31) sRPB[tid + 256] = r1;
  }
  float knr[16];
#pragma unroll
  for (int j = 0; j < 16; j++) knr[j] = p.in[I_KN][lq * 16 + j];

  const bf16_t* ckb = (const bf16_t*)(p.ws + OFF_CKB);
  const bf16_t* cvb = (const bf16_t*)(p.ws + OFF_CVB);
  auto tile_ptrs = [&](int kt, const bf16_t*& kp, const bf16_t*& vp) __attribute__((always_inline)) {
    if (latent && kt >= 8) {
      const size_t cb = ((size_t)(b * 8 + h) * 256 + (kt - 8) * 64 + lrow) * 64 + lq * 16;
      kp = ckb + cb; vp = cvb + cb;
    } else {
      const int tk0 = latent ? (NPTOK + b * 4096 + (rs + kt) * 64) : (seq * 256 + kt * 64);
      kp = u + (unsigned)(tk0 + lrow) * UST + 1296 + 512 + h * 64 + lq * 16;
      vp = kp + 512;
    }
  };
  uint4 kr0, kr1, vr0, vr1;
  {
    const bf16_t *kp, *vp;
    tile_ptrs(0, kp, vp);
    kr0 = *(const uint4*)kp; kr1 = *(const uint4*)(kp + 8);
    vr0 = *(const uint4*)vp; vr1 = *(const uint4*)(vp + 8);
  }
  for (int kt = 0; kt < nkt; kt++) {
    __syncthreads();
    const bool from_cache = latent && kt >= 8;
    {
      float f[16];
      unpack8(kr0, f); unpack8(kr1, f + 8);
      bf16_t vh[16];
      halves8(vr0, vh); halves8(vr1, vh + 8);
      const uint4 vs0 = vr0, vs1 = vr1;
      if (kt + 1 < nkt) {
        const bf16_t *kp, *vp;
        tile_ptrs(kt + 1, kp, vp);
        kr0 = *(const uint4*)kp; kr1 = *(const uint4*)(kp + 8);
        vr0 = *(const uint4*)vp; vr1 = *(const uint4*)(vp + 8);
      }
      if (!from_cache) {
        float ss = 0.f;
#pragma unroll
        for (int j = 0; j < 16; j++) ss += f[j] * f[j];
        ss = quad_sum(ss);
        const float sc = rsqrtf(ss * (1.f / 64.f) + EPSV);
#pragma unroll
        for (int j = 0; j < 16; j++) f[j] = f[j] * sc * knr[j];
      }
      *(uint4*)(sK + lrow * 72 + lq * 16) = pack8(f);
      *(uint4*)(sK + lrow * 72 + lq * 16 + 8) = pack8(f + 8);
#pragma unroll
      for (int j = 0; j < 16; j++) sVt[(lq * 16 + j) * 72 + lrow] = vh[j];
      if (!latent && kt == qt) {
        float g[16];
        unpack8(vs0, g); unpack8(vs1, g + 8);
        float* ok = p.out + OUT_NAK + ((unsigned)(seq * 8 + h) * 256 + kt * 64 + lrow) * 64 + lq * 16;
        float* ov = p.out + OUT_NAV + ((unsigned)(seq * 8 + h) * 256 + kt * 64 + lrow) * 64 + lq * 16;
#pragma unroll
        for (int j = 0; j < 16; j += 4) {
          *(float4*)(ok + j) = make_float4(f[j], f[j + 1], f[j + 2], f[j + 3]);
          *(float4*)(ov + j) = make_float4(g[j], g[j + 1], g[j + 2], g[j + 3]);
        }
      }
    }
    __syncthreads();
    f4v s[4];
    {
      const bf16_t* qa = sQ + (16 * w + (lane & 15)) * 72 + (lane >> 4) * 8;
      const s8v a0 = *(const s8v*)(qa);
      const s8v a1 = *(const s8v*)(qa + 32);
#pragma unroll
      for (int nt = 0; nt < 4; nt++) {
        const bf16_t* kb = sK + (nt * 16 + (lane & 15)) * 72 + (lane >> 4) * 8;
        f4v z = (f4v){0.f, 0.f, 0.f, 0.f};
        z = MFMA16(a0, *(const s8v*)(kb), z);
        z = MFMA16(a1, *(const s8v*)(kb + 32), z);
        s[nt] = z;
      }
    }
    if (latent && kt < 8) {
      const int drow = (rs + kt) - r + 7;
      const float* rp = sRPB + drow * 31;
#pragma unroll
      for (int nt = 0; nt < 4; nt++)
#pragma unroll
        for (int rr = 0; rr < 4; rr++) {
          const int cq = 16 * w + (lane >> 4) * 4 + rr;
          const int ck = nt * 16 + (lane & 15);
          int cs = cq - 8; cs = cs < 0 ? 0 : (cs > 48 ? 48 : cs);
          const bool valid = (ck >= cs) && (ck < cs + 16);
          const int dc = valid ? (ck - cq + 15) : 15;
          s[nt][rr] = valid ? (s[nt][rr] + rp[dc]) : -1e30f;
        }
    }
#pragma unroll
    for (int rr = 0; rr < 4; rr++) {
      float mx = fmaxf(fmaxf(s[0][rr], s[1][rr]), fmaxf(s[2][rr], s[3][rr]));
      mx = red16_max(mx);
      const float mn = fmaxf(m_run[rr], mx);
      const float alpha = __expf(m_run[rr] - mn);
      m_run[rr] = mn;
      float lp = 0.f;
      bf16_t* pr = sP + (16 * w + (lane >> 4) * 4 + rr) * 72 + (lane & 15);
      {
        const float p0 = __expf(s[0][rr] - mn), p1 = __expf(s[1][rr] - mn), p2 = __expf(s[2][rr] - mn), p3 = __expf(s[3][rr] - mn);
        lp = (p0 + p1) + (p2 + p3);
        const unsigned k01 = pack2(p0, p1), k23 = pack2(p2, p3);
        pr[0] = (bf16_t)(k01 & 0xffffu); pr[16] = (bf16_t)(k01 >> 16);
        pr[32] = (bf16_t)(k23 & 0xffffu); pr[48] = (bf16_t)(k23 >> 16);
      }
      l_run[rr] = l_run[rr] * alpha + lp;
#pragma unroll
      for (int d = 0; d < 4; d++) o[d][rr] *= alpha;
    }
    __syncthreads();
    {
      const bf16_t* pa = sP + (16 * w + (lane & 15)) * 72 + (lane >> 4) * 8;
      const s8v a0 = *(const s8v*)(pa);
      const s8v a1 = *(const s8v*)(pa + 32);
#pragma unroll
      for (int d = 0; d < 4; d++) {
        const bf16_t* vb = sVt + (d * 16 + (lane & 15)) * 72 + (lane >> 4) * 8;
        o[d] = MFMA16(a0, *(const s8v*)(vb), o[d]);
        o[d] = MFMA16(a1, *(const s8v*)(vb + 32), o[d]);
      }
    }
  }
#pragma unroll
  for (int rr = 0; rr < 4; rr++) {
    float l = l_run[rr];
    l = red16_sum(l);
    const float inv = __builtin_amdgcn_rcpf(l);
    const int tok = tq0 + 16 * w + (lane >> 4) * 4 + rr;
#pragma unroll
    for (int d = 0; d < 4; d++) hb[(unsigned)tok * 1024 + 512 + h * 64 + d * 16 + (lane & 15)] = f2bf(o[d][rr] * inv);
  }
}

#define SC_G 0
#define SC_PS 8192
#define SC_EGL 9216
#define SC_GS 9472
#define SC_RS 9600
#define SC_QS 10112
#define SC_QI 14720
#define SC_KS 19328
#define SC_KET 23936
#define SC_VT 29056
#define SC_P 39296
#define SC_ST 41856
#define SC_XH 60288
#define SC_WA 64896

template <int KIND, int DV>
__device__ __forceinline__ void scan_run(const Params& p, int seg, int hh, int dir, int mode, f4v (&S)[4][DV / 64], unsigned char* smem) {
  constexpr int NCT = DV / 64;
  constexpr int WDV = DV / 4;
  float* sG = (float*)(smem + SC_G);
  float* sPS = (float*)(smem + SC_PS);
  float* sEGL = (float*)(smem + SC_EGL);
  float* sGS = (float*)(smem + SC_GS);
  float* sRS = (float*)(smem + SC_RS);
  bf16_t* sQS = (bf16_t*)(smem + SC_QS);
  bf16_t* sQI = (bf16_t*)(smem + SC_QI);
  bf16_t* sKS = (bf16_t*)(smem + SC_KS);
  bf16_t* sKET = (bf16_t*)(smem + SC_KET);
  bf16_t* sVT = (bf16_t*)(smem + SC_VT);
  bf16_t* sP = (bf16_t*)(smem + SC_P);
  bf16_t* sST = (bf16_t*)(smem + SC_ST);
  bf16_t* sXH = (bf16_t*)(smem + SC_XH);
  float* sWA = (float*)(smem + SC_WA);
  bf16_t* u = (bf16_t*)(p.ws + OFF_U);
  bf16_t* hb = (bf16_t*)(p.ws + OFF_H);
  const int tid = opaque_tid(), lane = tid & 63, w = tid >> 6;
  const int li = tid >> 3, dg = tid & 7;
  const int tb = seg * 256;
  const bool prompt = seg < 32;

  __syncthreads();
  if (KIND == 1) {
    const float* wa = p.in[I_WA2] + dir * 16 * 256 + hh * 64;
    float t4[4];
#pragma unroll
    for (int i = 0; i < 4; i++) t4[i] = wa[((tid + 256 * i) >> 6) * 256 + ((tid + 256 * i) & 63)];
#pragma unroll
    for (int i = 0; i < 4; i++) sWA[tid + 256 * i] = t4[i];
  } else if (KIND == 2) {
    const float* lb = (const float*)(p.ws + OFF_LB) + dir * 256 + hh * 64;
    if (tid < 64) sWA[tid] = lb[tid];
  } else {
    float t3[3];
#pragma unroll
    for (int b3 = 0; b3 < 3; b3++) {
      const int i = tid + 256 * b3;
      const int blk = i >> 8, tap = (i >> 6) & 3, d = i & 63;
      const int ch = (blk == 0 ? 512 + (hh >> 2) * 64 : (blk == 1 ? 640 + (hh >> 2) * 64 : hh * 64)) + d;
      const float* srcp = tap < 3 ? (p.in[I_SCW] + tap * 768 + ch) : (p.in[I_SCB] + ch);
      t3[b3] = *srcp;
    }
#pragma unroll
    for (int b3 = 0; b3 < 3; b3++) sWA[tid + 256 * b3] = t3[b3];
  }
  float gtot[8];
#pragma unroll
  for (int j = 0; j < 8; j++) gtot[j] = 0.f;
  float bar[8];
#pragma unroll
  for (int j = 0; j < 8; j++) bar[j] = (KIND == 1) ? p.in[I_BA2][dir * 256 + hh * 64 + dg * 8 + j] : 0.f;
  float nwr[NCT];
#pragma unroll
  for (int ct = 0; ct < NCT; ct++) nwr[ct] = (KIND == 0) ? 0.f : ((KIND == 1) ? p.in[I_GLANW] : p.in[I_HGNW])[w * WDV + ct * 16 + (lane & 15)];
  float dtb = 0.f, aneg = 0.f, dsk = 0.f;
  if (KIND == 0) {
    dtb = p.in[I_DTB][dir * 8 + hh];
    aneg = -__expf(p.in[I_ALOG][dir * 8 + hh]);
    dsk = p.in[I_SSDD][hh];
  }
  __syncthreads();

  for (int c = 0; c < 8; c++) {
    if (mode != 0) {
#pragma unroll
      for (int kt = 0; kt < 4; kt++)
#pragma unroll
        for (int ct = 0; ct < NCT; ct++) {
          uint2 pk;
          pk.x = pack2(S[kt][ct][0], S[kt][ct][1]);
          pk.y = pack2(S[kt][ct][2], S[kt][ct][3]);
          *(uint2*)(sST + (w * WDV + ct * 16 + (lane & 15)) * 72 + kt * 16 + (lane >> 4) * 4) = pk;
        }
    }
    uint4 ofv0 = make_uint4(0, 0, 0, 0), ofv1 = make_uint4(0, 0, 0, 0);
    if (mode == 2) {
      const int tm = w * 64 + (3 - (lane >> 4)) * 16 + (lane & 15);
      const int tokm = tb + (7 - c) * 32 + (tm >> 3);
      const bf16_t* srcv = (KIND == 0) ? (u + (unsigned)tokm * UST + 2832 + hh * 64 + (tm & 7) * 8)
                                       : (hb + (unsigned)tokm * 1024 + (KIND - 1) * 512 + hh * 128 + (tm & 7) * 16);
      ofv0 = *(const uint4*)srcv;
      if (NCT == 2) ofv1 = *(const uint4*)(srcv + 8);
    }
    const int lidx = c * 32 + li;
    const int tok = tb + (dir ? (255 - lidx) : lidx);
    float q[8] = {0.f, 0.f, 0.f, 0.f, 0.f, 0.f, 0.f, 0.f}, k[8], g[8];
    if (KIND == 0) {
      const int pos = prompt ? (tok & 255) : (tok & 4095);
      const int T = prompt ? 256 : 4096;
      const bool hp = pos > 0, hn = pos < T - 1;
      const bf16_t* ur = u + (unsigned)tok * UST;
      const float dt_raw = bf2f(ur[1280 + dir * 8 + hh]) + dtb;
      const float dt = dt_raw > 20.f ? dt_raw : __logf(1.f + __expf(dt_raw));
      const float gg = aneg * dt;
#pragma unroll
      for (int j = 0; j < 8; j++) g[j] = gg;
      const int grp = hh >> 2;
      const uint4 z4 = make_uint4(0, 0, 0, 0);
      {
        const int col = 1024 + grp * 64 + dg * 8;
        float x0[8], x1[8], x2[8];
        unpack8(hp ? *(const uint4*)(ur - UST + col) : z4, x0);
        unpack8(*(const uint4*)(ur + col), x1);
        unpack8(hn ? *(const uint4*)(ur + UST + col) : z4, x2);
        const float* cw = sWA + 0 + dg * 8;
#pragma unroll
        for (int j = 0; j < 8; j++) k[j] = siluf(cw[192 + j] + cw[j] * x0[j] + cw[64 + j] * x1[j] + cw[128 + j] * x2[j]);
      }
      __builtin_amdgcn_sched_barrier(0);
      if (mode != 0) {
        const int col = 1152 + grp * 64 + dg * 8;
        float x0[8], x1[8], x2[8];
        unpack8(hp ? *(const uint4*)(ur - UST + col) : z4, x0);
        unpack8(*(const uint4*)(ur + col), x1);
        unpack8(hn ? *(const uint4*)(ur + UST + col) : z4, x2);
        const float* cw = sWA + 256 + dg * 8;
#pragma unroll
        for (int j = 0; j < 8; j++) q[j] = siluf(cw[192 + j] + cw[j] * x0[j] + cw[64 + j] * x1[j] + cw[128 + j] * x2[j]);
      }
      __builtin_amdgcn_sched_barrier(0);
      {
        const int col = 512 + hh * 64 + dg * 8;
        float x0[8], x1[8], x2[8];
        unpack8(hp ? *(const uint4*)(ur - UST + col) : z4, x0);
        unpack8(*(const uint4*)(ur + col), x1);
        unpack8(hn ? *(const uint4*)(ur + UST + col) : z4, x2);
        const float* cw = sWA + 512 + dg * 8;
        float xh[8];
#pragma unroll
        for (int j = 0; j < 8; j++) {
          xh[j] = siluf(cw[192 + j] + cw[j] * x0[j] + cw[64 + j] * x1[j] + cw[128 + j] * x2[j]);
          sVT[(dg * 8 + j) * 40 + li] = f2bf(xh[j] * dt);
        }
        if (mode == 2) *(uint4*)(sXH + li * 72 + dg * 8) = pack8(xh);
      }
    } else if (KIND == 1) {
      const bf16_t* ur = u + (unsigned)tok * UST;
      unpack8(*(const uint4*)(ur + hh * 64 + dg * 8), q);
      unpack8(*(const uint4*)(ur + 256 + hh * 64 + dg * 8), k);
#pragma unroll
      for (int j = 0; j < 8; j++) q[j] *= 0.125f;
      float ga[16];
      unpack8(*(const uint4*)(ur + 1536 + dir * 16), ga);
      unpack8(*(const uint4*)(ur + 1536 + dir * 16 + 8), ga + 8);
      float x[8];
#pragma unroll
      for (int j = 0; j < 8; j++) x[j] = bar[j];
#pragma unroll
      for (int rr = 0; rr < 16; rr++) {
        const float4 w0 = *(const float4*)(sWA + rr * 64 + dg * 8);
        const float4 w1 = *(const float4*)(sWA + rr * 64 + dg * 8 + 4);
        x[0] += ga[rr] * w0.x; x[1] += ga[rr] * w0.y; x[2] += ga[rr] * w0.z; x[3] += ga[rr] * w0.w;
        x[4] += ga[rr] * w1.x; x[5] += ga[rr] * w1.y; x[6] += ga[rr] * w1.z; x[7] += ga[rr] * w1.w;
      }
#pragma unroll
      for (int j = 0; j < 8; j++) g[j] = (fminf(x[j], 0.f) - __logf(1.f + __expf(-fabsf(x[j])))) * (1.f / 16.f);
      const bf16_t* vs = ur + 512 + hh * 128 + dg * 16;
      bf16_t vh[16];
      halves8(*(const uint4*)vs, vh);
      halves8(*(const uint4*)(vs + 8), vh + 8);
#pragma unroll
      for (int j = 0; j < 16; j++) sVT[(dg * 16 + j) * 40 + li] = vh[j];
    } else {
      const bf16_t* ur = u + (unsigned)tok * UST;
      unpack8(*(const uint4*)(ur + 1568 + hh * 64 + dg * 8), q);
      float fr[8];
      unpack8(*(const uint4*)(ur + 1824 + dir * 256 + hh * 64 + dg * 8), fr);
#pragma unroll
      for (int j = 0; j < 8; j++) {
        const float lbv = sWA[dg * 8 + j];
        const float f = lbv + (1.f - lbv) * sigmf(fr[j]);
        k[j] = 1.f - f;
        g[j] = __logf(f);
      }
      const bf16_t* vs = ur + 2336 + hh * 128 + dg * 16;
      bf16_t vh[16];
      halves8(*(const uint4*)vs, vh);
      halves8(*(const uint4*)(vs + 8), vh + 8);
#pragma unroll
      for (int j = 0; j < 16; j++) sVT[(dg * 16 + j) * 40 + li] = vh[j];
    }
    *(float4*)(sG + li * 64 + dg * 8) = make_float4(g[0], g[1], g[2], g[3]);
    *(float4*)(sG + li * 64 + dg * 8 + 4) = make_float4(g[4], g[5], g[6], g[7]);
    __syncthreads();
    {
      const int d = tid & 63, part = tid >> 6;
      float gv[8];
#pragma unroll
      for (int rr = 0; rr < 8; rr++) gv[rr] = sG[(part * 8 + rr) * 64 + d];
      float a = 0.f;
#pragma unroll
      for (int rr = 0; rr < 8; rr++) {
        a += gv[rr];
        sG[(part * 8 + rr) * 64 + d] = a;
      }
      sPS[part * 64 + d] = a;
    }
    __syncthreads();
    {
      float Gv[8], Gl[8];
      const float4 g0 = *(const float4*)(sG + li * 64 + dg * 8);
      const float4 g1 = *(const float4*)(sG + li * 64 + dg * 8 + 4);
      Gv[0] = g0.x; Gv[1] = g0.y; Gv[2] = g0.z; Gv[3] = g0.w; Gv[4] = g1.x; Gv[5] = g1.y; Gv[6] = g1.z; Gv[7] = g1.w;
      const int part = __builtin_amdgcn_readfirstlane(li >> 3);
#pragma unroll
      for (int j = 0; j < 8; j++) {
        const float p0 = sPS[dg * 8 + j], p1 = sPS[64 + dg * 8 + j], p2 = sPS[128 + dg * 8 + j], p3 = sPS[192 + dg * 8 + j];
        Gl[j] = p0 + p1 + p2 + p3;
        Gv[j] += (part > 0 ? p0 : 0.f) + (part > 1 ? p1 : 0.f) + (part > 2 ? p2 : 0.f);
      }
      float t[8];
#pragma unroll
      for (int j = 0; j < 8; j++) t[j] = k[j] * __expf(Gl[j] - Gv[j]);
#pragma unroll
      for (int j = 0; j < 8; j += 2) {
        const unsigned pk = pack2(t[j], t[j + 1]);
        sKET[(dg * 8 + j) * 40 + li] = (bf16_t)(pk & 0xffffu);
        sKET[(dg * 8 + j + 1) * 40 + li] = (bf16_t)(pk >> 16);
      }
      if (li == 0) {
#pragma unroll
        for (int j = 0; j < 8; j++) { sEGL[dg * 8 + j] = __expf(Gl[j]); gtot[j] += Gl[j]; }
      }
      if (mode != 0) {
        if (KIND == 0) {
          *(uint4*)(sQS + li * 72 + dg * 8) = pack8(q);
          *(uint4*)(sKS + li * 72 + dg * 8) = pack8(k);
#pragma unroll
          for (int j = 0; j < 8; j++) t[j] = q[j] * __expf(Gv[j]);
          *(uint4*)(sQI + li * 72 + dg * 8) = pack8(t);
          if (dg == 0) sGS[li] = Gv[0];
        } else {
#pragma unroll
          for (int j = 0; j < 8; j++) t[j] = q[j] * __expf(Gv[j]);
          const uint4 pq = pack8(t);
          *(uint4*)(sQS + li * 72 + dg * 8) = pq;
          *(uint4*)(sQI + li * 72 + dg * 8) = pq;
#pragma unroll
          for (int j = 0; j < 8; j++) t[j] = k[j] * __expf(-Gv[j]);
          *(uint4*)(sKS + li * 72 + dg * 8) = pack8(t);
        }
      }
    }
    __syncthreads();
    if (mode != 0) {
      const int ti = w >> 1, si = w & 1;
      const bf16_t* qa = sQS + (ti * 16 + (lane & 15)) * 72 + (lane >> 4) * 8;
      const bf16_t* kb = sKS + (si * 16 + (lane & 15)) * 72 + (lane >> 4) * 8;
      f4v z = (f4v){0.f, 0.f, 0.f, 0.f};
      z = MFMA16(*(const s8v*)(qa), *(const s8v*)(kb), z);
      z = MFMA16(*(const s8v*)(qa + 32), *(const s8v*)(kb + 32), z);
      const int scol = si * 16 + (lane & 15);
#pragma unroll
      for (int rr = 0; rr < 4; rr++) {
        const int trow = ti * 16 + (lane >> 4) * 4 + rr;
        float v = z[rr];
        if (KIND == 0) {
          const float df = sGS[trow] - sGS[scol];
          v *= __expf(fminf(df, 0.f));
        }
        v = (scol <= trow) ? v : 0.f;
        sP[trow * 40 + scol] = f2bf(v);
      }
    }
    __syncthreads();
    f4v o[2][NCT];
    if (mode != 0) {
#pragma unroll
      for (int rt = 0; rt < 2; rt++) {
        const s8v pa = *(const s8v*)(sP + (rt * 16 + (lane & 15)) * 40 + (lane >> 4) * 8);
        const bf16_t* qa = sQI + (rt * 16 + (lane & 15)) * 72 + (lane >> 4) * 8;
        const s8v q0 = *(const s8v*)(qa);
        const s8v q1 = *(const s8v*)(qa + 32);
#pragma unroll
        for (int ct = 0; ct < NCT; ct++) {
          const int vr = w * WDV + ct * 16 + (lane & 15);
          f4v z = (f4v){0.f, 0.f, 0.f, 0.f};
          z = MFMA16(pa, *(const s8v*)(sVT + vr * 40 + (lane >> 4) * 8), z);
          z = MFMA16(q0, *(const s8v*)(sST + vr * 72 + (lane >> 4) * 8), z);
          z = MFMA16(q1, *(const s8v*)(sST + vr * 72 + 32 + (lane >> 4) * 8), z);
          o[rt][ct] = z;
        }
      }
    }
#pragma unroll
    for (int kt = 0; kt < 4; kt++) {
      const s8v ka = *(const s8v*)(sKET + (kt * 16 + (lane & 15)) * 40 + (lane >> 4) * 8);
      const float4 eg = *(const float4*)(sEGL + kt * 16 + (lane >> 4) * 4);
#pragma unroll
      for (int ct = 0; ct < NCT; ct++) {
        const int vr = w * WDV + ct * 16 + (lane & 15);
        f4v z = S[kt][ct];
        z[0] *= eg.x; z[1] *= eg.y; z[2] *= eg.z; z[3] *= eg.w;
        S[kt][ct] = MFMA16(ka, *(const s8v*)(sVT + vr * 40 + (lane >> 4) * 8), z);
      }
    }
    if (mode == 1) {
      float pv[8 * NCT];
#pragma unroll
      for (int rt = 0; rt < 2; rt++)
#pragma unroll
        for (int rr = 0; rr < 4; rr++)
#pragma unroll
          for (int ct = 0; ct < NCT; ct++) pv[(rt * 4 + rr) * NCT + ct] = o[rt][ct][rr];
      const int tokf = tb + c * 32 + (tid >> 3);
      bf16_t* dst = (KIND == 0) ? (u + (unsigned)tokf * UST + 2832 + hh * 64 + (tid & 7) * 8)
                                : (hb + (unsigned)tokf * 1024 + (KIND - 1) * 512 + hh * 128 + (tid & 7) * 16);
      *(uint4*)dst = pack8(pv);
      if (NCT == 2) *(uint4*)(dst + 8) = pack8(pv + 8 * (NCT - 1));
    } else if (mode == 2) {
      float tot[2][NCT][4];
      float ssq[2][4];
      {
        float fv[8 * NCT];
        unpack8(ofv0, fv);
        if (NCT == 2) unpack8(ofv1, fv + 8 * (NCT - 1));
#pragma unroll
        for (int rt = 0; rt < 2; rt++)
#pragma unroll
          for (int rr = 0; rr < 4; rr++)
#pragma unroll
            for (int ct = 0; ct < NCT; ct++) tot[rt][ct][rr] = fv[((1 - rt) * 4 + (3 - rr)) * NCT + ct];
      }
      float gat[2][NCT][4];
      if (KIND != 0) {
        const int gcol = (KIND == 1) ? 1024 : 2848;
#pragma unroll
        for (int rt = 0; rt < 2; rt++)
#pragma unroll
          for (int rr = 0; rr < 4; rr++) {
            const int i = rt * 16 + (lane >> 4) * 4 + rr;
            const int li2 = c * 32 + i;
            const int tk = tb + (dir ? (255 - li2) : li2);
#pragma unroll
            for (int ct = 0; ct < NCT; ct++)
              gat[rt][ct][rr] = bf2f(u[(unsigned)tk * UST + gcol + hh * 128 + w * WDV + ct * 16 + (lane & 15)]);
          }
      }
#pragma unroll
      for (int rt = 0; rt < 2; rt++)
#pragma unroll
        for (int rr = 0; rr < 4; rr++) {
          const int i = rt * 16 + (lane >> 4) * 4 + rr;
          const int li2 = c * 32 + i;
          const int tk = tb + (dir ? (255 - li2) : li2);
          float sq = 0.f;
#pragma unroll
          for (int ct = 0; ct < NCT; ct++) {
            const int pc = w * WDV + ct * 16 + (lane & 15);
            float tv = o[rt][ct][rr] + tot[rt][ct][rr];
            if (KIND == 0) {
              tv += dsk * bf2f(sXH[i * 72 + pc]);
              u[(unsigned)tk * UST + 2832 + hh * 64 + pc] = f2bf(tv);
            }
            tot[rt][ct][rr] = tv;
            sq += tv * tv;
          }
          ssq[rt][rr] = sq;
        }
      if (KIND != 0) {
#pragma unroll
        for (int rt = 0; rt < 2; rt++)
#pragma unroll
          for (int rr = 0; rr < 4; rr++) {
            float sq = ssq[rt][rr];
            sq = red16_sum(sq);
            if ((lane & 15) == 0) sRS[w * 32 + rt * 16 + (lane >> 4) * 4 + rr] = sq;
          }
        __syncthreads();
#pragma unroll
        for (int rt = 0; rt < 2; rt++)
#pragma unroll
          for (int rr = 0; rr < 4; rr++) {
            const int i = rt * 16 + (lane >> 4) * 4 + rr;
            const int li2 = c * 32 + i;
            const int tk = tb + (dir ? (255 - li2) : li2);
            const float sq = sRS[i] + sRS[32 + i] + sRS[64 + i] + sRS[96 + i];
            const float scl = rsqrtf(sq * (1.f / 128.f) + EPSV);
#pragma unroll
            for (int ct = 0; ct < NCT; ct++) {
              const int pc = w * WDV + ct * 16 + (lane & 15);
              hb[(unsigned)tk * 1024 + (KIND - 1) * 512 + hh * 128 + pc] = f2bf(tot[rt][ct][rr] * scl * nwr[ct] * siluf(gat[rt][ct][rr]));
            }
          }
      }
    }
    __syncthreads();
  }
  if (mode == 0 && li == 0) {
#pragma unroll
    for (int j = 0; j < 8; j++) sEGL[dg * 8 + j] = __expf(gtot[j]);
  }
  __syncthreads();
}

template <int DV>
__device__ __forceinline__ void state_zero(f4v (&S)[4][DV / 64]) {
#pragma unroll
  for (int kt = 0; kt < 4; kt++)
#pragma unroll
    for (int ct = 0; ct < DV / 64; ct++) S[kt][ct] = (f4v){0.f, 0.f, 0.f, 0.f};
}
#define PIN_U4(a) asm volatile("" ::"v"((a).x), "v"((a).y), "v"((a).z), "v"((a).w) : "memory")
template <int DV>
__device__ __forceinline__ void state_load_f32(f4v (&S)[4][DV / 64], const float* src  , unsigned char* smem) {
  const int tid = opaque_tid(), lane = tid & 63, w = tid >> 6;
  float* l = (float*)smem;
  __syncthreads();
  {
    float4 t[DV / 16];
#pragma unroll
    for (int i = 0; i < DV / 16; i++) t[i] = ((const float4*)src)[tid + 256 * i];
#pragma unroll
    for (int i = 0; i < DV / 16; i++) PIN_U4(t[i]);
#pragma unroll
    for (int i = 0; i < DV / 16; i++) ((float4*)l)[tid + 256 * i] = t[i];
  }
  __syncthreads();
  const float* lb = l + ((lane >> 4) * 4) * DV + w * (DV / 4) + (lane & 15);
#pragma unroll
  for (int kt = 0; kt < 4; kt++)
#pragma unroll
    for (int ct = 0; ct < DV / 64; ct++)
#pragma unroll
      for (int r = 0; r < 4; r++) S[kt][ct][r] = lb[(kt * 16 + r) * DV + ct * 16];
}
template <int DV>
__device__ __forceinline__ void state_store_f32(const f4v (&S)[4][DV / 64], float* dst, unsigned char* smem) {
  const int tid = opaque_tid(), lane = tid & 63, w = tid >> 6;
  float* l = (float*)smem;
  __syncthreads();
  float* lb = l + ((lane >> 4) * 4) * DV + w * (DV / 4) + (lane & 15);
#pragma unroll
  for (int kt = 0; kt < 4; kt++)
#pragma unroll
    for (int ct = 0; ct < DV / 64; ct++)
#pragma unroll
      for (int r = 0; r < 4; r++) lb[(kt * 16 + r) * DV + ct * 16] = S[kt][ct][r];
  __syncthreads();
  {
    float4 t[DV / 16];
#pragma unroll
    for (int i = 0; i < DV / 16; i++) t[i] = ((const float4*)l)[tid + 256 * i];
#pragma unroll
    for (int i = 0; i < DV / 16; i++) ((float4*)dst)[tid + 256 * i] = t[i];
  }
}
template <int DV>
__device__ __forceinline__ void state_combine(f4v (&S)[4][DV / 64], const bf16_t* sl, const float* D, unsigned char* smem) {
  const int tid = opaque_tid(), lane = tid & 63, w = tid >> 6;
  bf16_t* l = (bf16_t*)smem;
  float* ld = (float*)(smem + 16384);
  __syncthreads();
  {
    uint4 t[4];
#pragma unroll
    for (int i = 0; i < 4; i++) t[i] = ((const uint4*)sl)[tid + 256 * i];
    const float dv = D[tid & 63];
#pragma unroll
    for (int i = 0; i < 4; i++) PIN_U4(t[i]);
    asm volatile("" ::"v"(dv) : "memory");
#pragma unroll
    for (int i = 0; i < 4; i++) ((uint4*)l)[tid + 256 * i] = t[i];
    if (tid < 64) ld[tid] = dv;
  }
  __syncthreads();
  const bf16_t* lb = l + ((lane >> 4) * 4) * 128 + w * (DV / 4) + (lane & 15);
  const float* ldb = ld + (lane >> 4) * 4;
#pragma unroll
  for (int kt = 0; kt < 4; kt++)
#pragma unroll
    for (int r = 0; r < 4; r++) {
      const float dd = ldb[kt * 16 + r];
#pragma unroll
      for (int ct = 0; ct < DV / 64; ct++) S[kt][ct][r] = S[kt][ct][r] * dd + bf2f(lb[(kt * 16 + r) * 128 + ct * 16]);
    }
}
template <int DV>
__device__ __forceinline__ void state_store_bf16(const f4v (&S)[4][DV / 64], bf16_t* dst, unsigned char* smem) {
  const int tid = opaque_tid(), lane = tid & 63, w = tid >> 6;
  bf16_t* l = (bf16_t*)smem;
  __syncthreads();
  bf16_t* lb = l + ((lane >> 4) * 4) * 128 + w * (DV / 4) + (lane & 15);
#pragma unroll
  for (int kt = 0; kt < 4; kt++)
#pragma unroll
    for (int ct = 0; ct < DV / 64; ct++)
#pragma unroll
      for (int r = 0; r < 4; r++) lb[(kt * 16 + r) * 128 + ct * 16] = f2bf(S[kt][ct][r]);
  __syncthreads();
  {
    uint4 t[4];
#pragma unroll
    for (int i = 0; i < 4; i++) t[i] = ((const uint4*)l)[tid + 256 * i];
#pragma unroll
    for (int i = 0; i < 4; i++) ((uint4*)dst)[tid + 256 * i] = t[i];
  }
}

template <int KIND, int DV>
__device__ __forceinline__ void scan_work(const Params& p, bool local, int seg, int hg, int hh, int ldir, const float* s0f, const float* s0b,
                                          float* outf, float* outb, int nheads, unsigned char* smem) {
  f4v S[4][DV / 64];
  const bf16_t* SL = (const bf16_t*)(p.ws + OFF_SL);
  const float* DL = (const float*)(p.ws + OFF_DL);
  const int npass = local ? 1 : 2;
  for (int pass = 0; pass < npass; pass++) {
    const int mode = local ? 0 : pass + 1;
    const int dir = local ? ldir : pass;
    state_zero<DV>(S);
    if (!local && seg >= 32) {
      const int sq = (seg - 32) >> 4, j = (seg - 32) & 15;
      state_load_f32<DV>(S, (dir ? s0b : s0f) + (unsigned)(sq * nheads + hh) * 64 * DV, smem);
      const int jbeg = dir ? 15 : 0, jstep = dir ? -1 : 1;
      for (int jj = jbeg; jj != j; jj += jstep) {
        const size_t idx = ((size_t)((sq * 16 + jj) * 8 + hg) * 2 + dir);
        state_combine<DV>(S, SL + idx * 8192, DL + idx * 64, smem);
      }
    }
    scan_run<KIND, DV>(p, seg, hh, dir, mode, S, smem);
    if (local) {
      const size_t idx = ((size_t)((seg - 32) * 8 + hg) * 2 + dir);
      if (opaque_tid() < 64) ((float*)(p.ws + OFF_DL))[idx * 64 + opaque_tid()] = ((float*)(smem + SC_EGL))[opaque_tid()];
      state_store_bf16<DV>(S, (bf16_t*)(p.ws + OFF_SL) + idx * 8192, smem);
    } else if (seg < 32) {
      state_store_f32<DV>(S, (dir ? outb : outf) + (unsigned)(seg * nheads + hh) * 64 * DV, smem);
    }
  }
}

__device__ __forceinline__ void ssd_post_phase(const Params& p) {
  const bf16_t* u = (const bf16_t*)(p.ws + OFF_U);
  bf16_t* hb = (bf16_t*)(p.ws + OFF_H);
  const int lane = opaque_tid() & 63, wave = opaque_tid() >> 6;
  const float* nw = p.in[I_SSDNW] + lane * 8;
  float nwv[8];
#pragma unroll
  for (int j = 0; j < 8; j++) nwv[j] = nw[j];
  for (int item = blockIdx.x; item < NTOK / 8; item += gridDim.x) {
    const int row = item * 8 + wave * 2;
    const uint4 ro0 = *(const uint4*)(u + (unsigned)row * UST + 2832 + lane * 8);
    const uint4 rz0 = *(const uint4*)(u + (unsigned)row * UST + lane * 8);
    const uint4 ro1 = *(const uint4*)(u + (unsigned)(row + 1) * UST + 2832 + lane * 8);
    const uint4 rz1 = *(const uint4*)(u + (unsigned)(row + 1) * UST + lane * 8);
    float o0[8], z0[8], o1[8], z1[8];
    unpack8(ro0, o0); unpack8(rz0, z0); unpack8(ro1, o1); unpack8(rz1, z1);
    float ss0 = 0.f, ss1 = 0.f;
#pragma unroll
    for (int j = 0; j < 8; j++) {
      o0[j] = o0[j] * siluf(z0[j]); ss0 += o0[j] * o0[j];
      o1[j] = o1[j] * siluf(z1[j]); ss1 += o1[j] * o1[j];
    }
#pragma unroll
    for (int m = 32; m >= 1; m >>= 1) { ss0 += __shfl_xor(ss0, m); ss1 += __shfl_xor(ss1, m); }
    const float r0 = rsqrtf(ss0 * (1.f / 512.f) + EPSV), r1 = rsqrtf(ss1 * (1.f / 512.f) + EPSV);
#pragma unroll
    for (int j = 0; j < 8; j++) { o0[j] = o0[j] * r0 * nwv[j]; o1[j] = o1[j] * r1 * nwv[j]; }
    *(uint4*)(hb + (unsigned)row * 1024 + lane * 8) = pack8(o0);
    *(uint4*)(hb + (unsigned)(row + 1) * 1024 + lane * 8) = pack8(o1);
  }
}

template <int layer>
__device__ __forceinline__ void layer_body(const Params& p, unsigned char* smem, const XcdBarrier& xb) {
  const int bid = blockIdx.x, nb = gridDim.x;
  bf16_t* Wt_in = (bf16_t*)(p.ws + OFF_WIN);
  bf16_t* Wt_out = (bf16_t*)(p.ws + OFF_WOUT);
  bf16_t* Wt_up = (bf16_t*)(p.ws + OFF_WUP);
  bf16_t* Wt_dn = (bf16_t*)(p.ws + OFF_WDN);
  bf16_t* ub = (bf16_t*)(p.ws + OFF_U);
  bf16_t* hb = (bf16_t*)(p.ws + OFF_H);
  const float* mods = (const float*)(p.ws + OFF_MODS);
  const bf16_t* zrow = (const bf16_t*)(p.ws + OFF_ZROW);
    const float* mods_l = mods + (unsigned)layer * 5 * 6144;
    const int NIN = layer == 0 ? 2832 : 3360;
    normmod_phase(p, layer, 0, layer == 0);
    xcd_barrier(xb);
    {
      const int NT = (NIN + 127) >> 7;
      for (int r = 0;; r++) {
        int mt, nt;
        if (!tile_swizzle(r, 96, NT, mt, nt)) break;
        ARowPlain af{1024};
        BRowClamp bf{1024, nt * 128, NIN};
        EpiStoreU ep{ub, mt * 256, nt * 128, NIN};
        gemm_tile(hb + (unsigned)mt * 256 * 1024, Wt_in, zrow, af, bf, 1024, ep, smem);
      }
    }
    xcd_barrier(xb);
    if (layer == 0) {
      for (int it = bid; it < 3072 + 1024; it += nb) {
        if (it < 2048) attn_item(p, 1024 + it, smem);
        else if (it < 3072) attn_item(p, it - 2048, smem);
        else {
          const int t = it - 3072;
          scan_work<0, 64>(p, true, 32 + (t >> 4), (t >> 1) & 7, (t >> 1) & 7, t & 1, nullptr, nullptr, nullptr, nullptr, 8, smem);
        }
      }
      xcd_barrier(xb);
      for (int it = bid; it < 768; it += nb) {
        const int seg = 95 - (it >> 3), hg = it & 7;
        scan_work<0, 64>(p, false, seg, hg, hg, 0, p.in[I_SSDF], p.in[I_SSDB], p.out + OUT_SSDF, p.out + OUT_SSDB, 8, smem);
      }
      {
        const int idle0 = (768 - nb) > 0 ? (768 - nb) : 0;
        const int n_in = convert_ntiles(1024, 3360), n_up = convert_ntiles(1024, 5632), n_dn = convert_ntiles(2816, 1024);
        if (bid >= idle0)
          for (int it = bid - idle0; it < 384 + n_in + n_up + n_dn; it += nb - idle0) {
            int t = it;
            if (t < 384) { mods_item(p, 384 + t, smem); continue; }
            t -= 384;
            if (t < n_in) { convert_tile(p.in[I_WIN1], Wt_in, 1024, 3360, t, smem); continue; }
            t -= n_in;
            if (t < n_up) { convert_tile(p.in[I_WUP], Wt_up, 1024, 5632, t, smem); continue; }
            t -= n_up;
            convert_tile(p.in[I_WDN], Wt_dn, 2816, 1024, t, smem);
          }
      }
      xcd_barrier(xb);
      ssd_post_phase(p);
      xcd_barrier(xb);
    } else {
      for (int t = bid; t < 1024; t += nb) {
        const int ss = t >> 4, hg = (t >> 1) & 7, dir = t & 1;
        if (hg < 4) scan_work<1, 128>(p, true, 32 + ss, hg, hg, dir, nullptr, nullptr, nullptr, nullptr, 4, smem);
        else scan_work<2, 128>(p, true, 32 + ss, hg, hg - 4, dir, nullptr, nullptr, nullptr, nullptr, 4, smem);
      }
      xcd_barrier(xb);
      for (int it = bid; it < 768; it += nb) {
        const int seg = 95 - (it >> 3), hg = it & 7;
        if (hg < 4) scan_work<1, 128>(p, false, seg, hg, hg, 0, p.in[I_GLAF], p.in[I_GLAB], p.out + OUT_GLAF, p.out + OUT_GLAB, 4, smem);
        else scan_work<2, 128>(p, false, seg, hg, hg - 4, 0, p.in[I_HGF], p.in[I_HGB], p.out + OUT_HGF, p.out + OUT_HGB, 4, smem);
      }
      {
        const int idle0 = (768 - nb) > 0 ? (768 - nb) : 0;
        const int n_up = convert_ntiles(1024, 5632), n_dn = convert_ntiles(2816, 1024);
        if (bid >= idle0)
          for (int it = bid - idle0; it < n_up + n_dn; it += nb - idle0) {
            if (it < n_up) convert_tile(p.in[I_WUP] + (unsigned)1024 * 5632, Wt_up, 1024, 5632, it, smem);
            else convert_tile(p.in[I_WDN] + (unsigned)2816 * 1024, Wt_dn, 2816, 1024, it - n_up, smem);
          }
      }
      xcd_barrier(xb);
    }
    {
      for (int r = 0;; r++) {
        int mt, nt;
        if (!tile_swizzle(r, 96, 8, mt, nt)) break;
        ARowPlain af{1024};
        BRowClamp bf{1024, nt * 128, 1024};
        EpiResid ep{p.in[I_XP], p.in[I_XS], layer == 0, p.out, mods_l + 2048, mt * 256, nt * 128};
        gemm_tile(hb + (unsigned)mt * 256 * 1024, Wt_out, zrow, af, bf, 1024, ep, smem);
      }
    }
    xcd_barrier(xb);
    normmod_phase(p, layer, 1, false);
    if (layer == 0) {
      const int n_out = convert_ntiles(1024, 1024);
      for (int it = bid; it < n_out; it += nb) convert_tile(p.in[I_WOUT1], Wt_out, 1024, 1024, it, smem);
    }
    xcd_barrier(xb);
    {
      bf16_t* act = ub;
      const float* cw = p.in[I_FCW] + (unsigned)layer * 3 * 5632;
      const float* cb = p.in[I_FCB] + (unsigned)layer * 5632;
      for (int r = 0;; r++) {
        int mt, nt;
        if (!tile_swizzle(r, 104, 44, mt, nt)) break;
        if (mt >= 100) continue;
        int lo, hi, t0;
        bool halo;
        if (mt < 32) { lo = mt * 256; hi = lo + 256; t0 = lo; halo = false; }
        else { const int m2 = mt - 32; const int sq = m2 / 17; const int j = m2 - sq * 17; lo = NPTOK + sq * 4096; hi = lo + 4096; t0 = lo + 254 * j - 1; halo = true; }
        ARowHalo af{t0, lo, hi};
        BRowUp bf{nt * 64};
        EpiConv ep{act, cw, cb, t0, hi, nt * 64, halo};
        gemm_tile(hb, Wt_up, zrow, af, bf, 1024, ep, smem);
      }
    }
    xcd_barrier(xb);
    {
      const bf16_t* act = ub;
      for (int r = 0;; r++) {
        int mt, nt;
        if (!tile_swizzle(r, 96, 8, mt, nt)) break;
        ARowPlain af{FFN};
        BRowClamp bf{FFN, nt * 128, 1024};
        EpiResid ep{p.in[I_XP], p.in[I_XS], false, p.out, mods_l + 5120, mt * 256, nt * 128};
        gemm_tile(act + (unsigned)mt * 256 * FFN, Wt_dn, zrow, af, bf, FFN, ep, smem);
      }
    }
    if (layer == 0) xcd_barrier(xb);
}

__global__ void __launch_bounds__(256, 2) __attribute__((amdgpu_waves_per_eu(2, 2))) mega(Params p) {
  __shared__ __align__(16) unsigned char smem[SMEM_BYTES];
  __shared__ uint4 xb_words;
  if (p.out == nullptr) { cg::grid_group grid = cg::this_grid(); grid.sync(); }
  if (threadIdx.x == 0) xb_words = make_uint4(0u, 0u, 0u, 0u);
  __syncthreads();
  const XcdBarrier xb = xcd_barrier_post((unsigned*)(p.ws + OFF_BAR), (volatile LAS unsigned*)&xb_words);
  const int bid = blockIdx.x, nb = gridDim.x;
  bf16_t* Wt_in = (bf16_t*)(p.ws + OFF_WIN);
  bf16_t* Wt_out = (bf16_t*)(p.ws + OFF_WOUT);
  bf16_t* Wt_up = (bf16_t*)(p.ws + OFF_WUP);
  bf16_t* Wt_dn = (bf16_t*)(p.ws + OFF_WDN);
  bf16_t* ub = (bf16_t*)(p.ws + OFF_U);
  bf16_t* hb = (bf16_t*)(p.ws + OFF_H);
  const float* mods = (const float*)(p.ws + OFF_MODS);

  {
    const int n_in = convert_ntiles(1024, 2832), n_out = convert_ntiles(1024, 1024);
    const int total = 384 + n_in + n_out;
    for (int it = bid; it < total; it += nb) {
      int t = it;
      if (t < 384) { mods_item(p, t, smem); continue; }
      t -= 384;
      if (t < n_in) { convert_tile(p.in[I_WIN0], Wt_in, 1024, 2832, t, smem); continue; }
      t -= n_in;
      convert_tile(p.in[I_WOUT0], Wt_out, 1024, 1024, t, smem);
    }
  }
  {
    const int g = blockIdx.x * 256 + (opaque_tid() & 255);
    for (int i = g; i < 131072; i += gridDim.x * 256) {
      const int which = i >> 16, e = (i & 65535) * 8;
      const float* src = (which ? p.in[I_CV] : p.in[I_CK]) + e;
      const float4 a = *(const float4*)src, c = *(const float4*)(src + 4);
      uint4 o; o.x = pack2(a.x, a.y); o.y = pack2(a.z, a.w); o.z = pack2(c.x, c.y); o.w = pack2(c.z, c.w);
      *(uint4*)((bf16_t*)(p.ws + (which ? OFF_CVB : OFF_CKB)) + e) = o;
    }
  }
  xcd_barrier(xb);

  layer_body<0>(p, smem, xb);
  layer_body<1>(p, smem, xb);
}

extern "C" void kernel_launch(void* const* d_in, const int* in_sizes, int n_in,
                              void* d_out, int out_size, void* d_ws, size_t ws_size,
                              hipStream_t stream) {
  static int grid_blocks = 0;
  if (!grid_blocks) {
    int dev = 0, cus = 0, per_cu = 0;
    (void)hipGetDevice(&dev);
    (void)hipDeviceGetAttribute(&cus, hipDeviceAttributeMultiprocessorCount, dev);
    (void)hipOccupancyMaxActiveBlocksPerMultiprocessor(&per_cu, mega, 256, 0);
    if (per_cu > 2) per_cu = 2;
    if (per_cu < 1) per_cu = 1;
    grid_blocks = cus * per_cu;
  }
  Params p{};
  for (int i = 0; i < 37; i++) p.in[i] = (const float*)d_in[i];
  p.out = (float*)d_out;
  p.ws = (unsigned char*)d_ws;
  void* args[] = {&p};
  (void)hipMemsetAsync((unsigned char*)d_ws + OFF_BAR, 0, XCD_BAR_WORDS * 4, stream);
  hipError_t e = hipLaunchCooperativeKernel((void*)mega, dim3(grid_blocks), dim3(256), args, 0, stream);
  if (e != hipSuccess) fprintf(stderr, "cooperative launch failed: %s (grid %d)\n", hipGetErrorString(e), grid_blocks);
}
```
